# Optimizing an MI355X kernel written in HIP

```python
import math
import jax, jax.numpy as jnp
from jax import lax
import numpy as np

D_MODEL = 1024
BATCH = 8
SEQ = 8192
DEPTH = 1

EPS = 1e-6
GLA_HEADS = 4
GLA_DK = D_MODEL // 16
GLA_DV = D_MODEL // 8
GLA_GATE_RANK = 16
GLA_GATE_NORM = 16.0
GLA_CHUNK = 64
DIFF_HEADS = 4
DIFF_DH = D_MODEL // 16
DIFF_DV = 2 * DIFF_DH
Q_BLOCK = 128
REL_BUCKETS = 32
REL_MAX_DIST = 128
N_EXPERTS = 32
TOP_K = 4
D_FF = D_MODEL
SWIGLU_LIMIT = 7.0
SWIGLU_ALPHA = 1.702
MOE_BLOCK = 512
GLA_QK_W = GLA_HEADS * GLA_DK
GLA_V_W = GLA_HEADS * GLA_DV
DIFF_QK_W = DIFF_HEADS * 2 * DIFF_DH
DIFF_V_W = DIFF_HEADS * DIFF_DV
D_MIX = GLA_V_W + DIFF_V_W
IN_SIZES = (GLA_QK_W, GLA_QK_W, GLA_V_W, GLA_GATE_RANK, GLA_V_W, DIFF_QK_W, DIFF_QK_W, DIFF_V_W)
IN_WIDTH = sum(IN_SIZES)

kernel_name = 'hymba_gla_diffattn_moe_block'


def _split_points():
    pts, acc = [], 0
    for s in IN_SIZES[:-1]:
        acc += s
        pts.append(acc)
    return pts


def _rmsnorm(x, gain):
    xf = x.astype(jnp.float32)
    y = xf * lax.rsqrt(jnp.mean(xf * xf, axis=-1, keepdims=True) + EPS)
    return (y * gain.astype(jnp.float32)).astype(x.dtype)


def _t5_causal_bucket(rel):
    n = jnp.maximum(-rel, 0)
    max_exact = REL_BUCKETS // 2
    nf = jnp.maximum(n, 1).astype(jnp.float32)
    large = max_exact + (jnp.log(nf / max_exact) / math.log(REL_MAX_DIST / max_exact)
                         * (REL_BUCKETS - max_exact)).astype(jnp.int32)
    large = jnp.minimum(large, REL_BUCKETS - 1)
    return jnp.where(n < max_exact, n, large)


def _gla_group(q, k, v, g_low, r, w_gate2, b_gate2, out_gain):
    B, S, _ = q.shape
    C = GLA_CHUNK
    N = S // C
    f32 = jnp.float32
    log_a = jax.nn.log_sigmoid((g_low @ w_gate2 + b_gate2).astype(f32)) / GLA_GATE_NORM

    def heads(t, d):
        return t.reshape(B, N, C, GLA_HEADS, d).transpose(0, 3, 1, 2, 4).astype(f32)

    qh = heads(q, GLA_DK) * (GLA_DK ** -0.5)
    kh = heads(k, GLA_DK)
    vh = heads(v, GLA_DV)
    b = jnp.cumsum(heads(log_a, GLA_DK), axis=3)
    b_last = b[:, :, :, -1:, :]
    q_dec = qh * jnp.exp(b)
    att = jnp.einsum('bhntd,bhnsd->bhnts', q_dec, kh * jnp.exp(-b))
    causal = jnp.tril(jnp.ones((C, C), dtype=bool))
    o_intra = jnp.einsum('bhnts,bhnse->bhnte', jnp.where(causal, att, 0.0), vh)
    kv = jnp.einsum('bhnsd,bhnse->bhnde', kh * jnp.exp(b_last - b), vh)
    decay = jnp.exp(b_last[:, :, :, 0, :])

    def step(state, inp):
        kv_n, dec_n = inp
        return state * dec_n[..., None] + kv_n, state

    init = jnp.zeros((B, GLA_HEADS, GLA_DK, GLA_DV), f32)
    _, states = lax.scan(step, init, (jnp.moveaxis(kv, 2, 0), jnp.moveaxis(decay, 2, 0)))
    states = jnp.moveaxis(states, 0, 2)
    o = o_intra + jnp.einsum('bhntd,bhnde->bhnte', q_dec, states)
    o = o.transpose(0, 2, 3, 1, 4).reshape(B, S, GLA_HEADS, GLA_DV)
    o = _rmsnorm(o, out_gain).reshape(B, S, GLA_V_W)
    return o.astype(r.dtype) * jax.nn.silu(r)


def _diff_group(q, k, v, q_gain, k_gain, lam_q1, lam_k1, lam_q2, lam_k2, sub_gain, rel_bias, lam_init):
    B, S, _ = q.shape
    H, d = DIFF_HEADS, DIFF_DH
    f32 = jnp.float32
    q = _rmsnorm(q.reshape(B, S, H, 2, d), q_gain)
    k = _rmsnorm(k.reshape(B, S, H, 2, d), k_gain)
    v = v.reshape(B, S, H, DIFF_DV)
    lam = (jnp.exp(jnp.sum(lam_q1.astype(f32) * lam_k1.astype(f32)))
           - jnp.exp(jnp.sum(lam_q2.astype(f32) * lam_k2.astype(f32))) + lam_init)
    scale = d ** -0.5
    nq = S // Q_BLOCK
    q_blocks = q.reshape(B, nq, Q_BLOCK, H, 2, d).transpose(1, 0, 2, 3, 4, 5)
    k_pos = jnp.arange(S)

    def block(args):
        q_blk, i = args
        q_pos = i * Q_BLOCK + jnp.arange(Q_BLOCK)
        rel = k_pos[None, :] - q_pos[:, None]
        bias = rel_bias[_t5_causal_bucket(rel)].transpose(2, 0, 1).astype(f32)
        s = jnp.einsum('bqhcd,bkhcd->bhcqk', q_blk, k, preferred_element_type=f32) * scale
        s = s + bias[None, :, None]
        s = jnp.where(rel <= 0, s, -1e30)
        p = jax.nn.softmax(s, axis=-1)
        a = p[:, :, 0] - lam * p[:, :, 1]
        return jnp.einsum('bhqk,bkhe->bqhe', a.astype(v.dtype), v)

    o = lax.map(block, (q_blocks, jnp.arange(nq)))
    o = o.transpose(1, 0, 2, 3, 4).reshape(B, S, H, DIFF_DV)
    o = _rmsnorm(o, sub_gain) * (1.0 - lam_init)
    return o.reshape(B, S, DIFF_V_W).astype(v.dtype)


def _moe(h, w_router, b_router, w_gate_up, b_gate_up, w_down, b_down):
    B, S, D = h.shape
    T = B * S
    A = T * TOP_K
    f32 = jnp.float32
    xt = h.reshape(T, D)
    logits = (xt @ w_router + b_router).astype(f32)
    top_val, top_idx = lax.top_k(logits, TOP_K)
    gates = jax.nn.softmax(top_val, axis=-1)
    e_flat = top_idx.reshape(-1)
    tok_flat = jnp.repeat(jnp.arange(T, dtype=jnp.int32), TOP_K)
    g_flat = gates.reshape(-1)
    order = jnp.argsort(e_flat)
    e_sorted = e_flat[order]
    counts = jnp.bincount(e_flat, length=N_EXPERTS)
    starts = jnp.cumsum(counts) - counts
    padded = (counts + MOE_BLOCK - 1) // MOE_BLOCK * MOE_BLOCK
    pad_end = jnp.cumsum(padded)
    pad_start = pad_end - padded
    dest = pad_start[e_sorted] + (jnp.arange(A) - starts[e_sorted])
    n_blocks = -(-A // MOE_BLOCK) + N_EXPERTS
    P = n_blocks * MOE_BLOCK
    slot_tok = jnp.full((P,), T, jnp.int32).at[dest].set(tok_flat[order])
    slot_gate = jnp.zeros((P,), f32).at[dest].set(g_flat[order])
    block_exp = jnp.minimum(jnp.searchsorted(pad_end, jnp.arange(n_blocks) * MOE_BLOCK, side='right'),
                            N_EXPERTS - 1)
    x_pad = jnp.concatenate([xt, jnp.zeros((1, D), xt.dtype)], axis=0)

    def expert_block(args):
        e, toks, g = args
        gu = x_pad[toks] @ w_gate_up[e] + b_gate_up[e]
        x_glu, x_lin = gu[:, :D_FF], gu[:, D_FF:]
        x_glu = jnp.minimum(x_glu, SWIGLU_LIMIT)
        x_lin = jnp.clip(x_lin, -SWIGLU_LIMIT, SWIGLU_LIMIT)
        hid = x_glu * jax.nn.sigmoid(SWIGLU_ALPHA * x_glu) * (x_lin + 1.0)
        y = hid @ w_down[e] + b_down[e]
        return y * g[:, None].astype(y.dtype)

    ys = lax.map(expert_block, (block_exp, slot_tok.reshape(n_blocks, MOE_BLOCK),
                                slot_gate.reshape(n_blocks, MOE_BLOCK)))
    out = jax.ops.segment_sum(ys.reshape(P, D), slot_tok, num_segments=T + 1)[:T]
    return out.reshape(B, S, D).astype(h.dtype)


def setup_inputs(seed: int = 0) -> dict:
    key = jax.random.key(seed)
    ks = jax.random.split(key, 24)
    L = DEPTH
    f32 = jnp.float32

    def w(k, shape, fan_in):
        return jax.random.normal(k, shape, f32) * (fan_in ** -0.5)

    def gain(k, shape):
        return 1.0 + 0.02 * jax.random.normal(k, shape, f32)

    def small(k, shape, s):
        return s * jax.random.normal(k, shape, f32)

    return {
        'x': jax.random.normal(ks[0], (BATCH, SEQ, D_MODEL), f32),
        'norm1_gain': gain(ks[1], (L, D_MODEL)),
        'w_in': w(ks[2], (L, D_MODEL, IN_WIDTH), D_MODEL),
        'w_gla_gate2': w(ks[3], (L, GLA_GATE_RANK, GLA_QK_W), GLA_GATE_RANK),
        'b_gla_gate2': small(ks[4], (L, GLA_QK_W), 0.1),
        'gla_out_gain': gain(ks[5], (L, GLA_DV)),
        'diff_q_gain': gain(ks[6], (L, DIFF_DH)),
        'diff_k_gain': gain(ks[7], (L, DIFF_DH)),
        'lam_q1': small(ks[8], (L, DIFF_DH), 0.1),
        'lam_k1': small(ks[9], (L, DIFF_DH), 0.1),
        'lam_q2': small(ks[10], (L, DIFF_DH), 0.1),
        'lam_k2': small(ks[11], (L, DIFF_DH), 0.1),
        'diff_sub_gain': gain(ks[12], (L, DIFF_DV)),
        'rel_bias': small(ks[13], (REL_BUCKETS, DIFF_HEADS), 0.5),
        'w_out': w(ks[14], (L, D_MIX, D_MODEL), D_MIX),
        'norm2_gain': gain(ks[15], (L, D_MODEL)),
        'w_router': w(ks[16], (L, D_MODEL, N_EXPERTS), D_MODEL),
        'b_router': small(ks[17], (L, N_EXPERTS), 0.01),
        'w_gate_up': w(ks[18], (L, N_EXPERTS, D_MODEL, 2 * D_FF), D_MODEL),
        'b_gate_up': small(ks[19], (L, N_EXPERTS, 2 * D_FF), 0.01),
        'w_down': w(ks[20], (L, N_EXPERTS, D_FF, D_MODEL), D_FF),
        'b_down': small(ks[21], (L, N_EXPERTS, D_MODEL), 0.01),
    }


def reference(x, norm1_gain, w_in, w_gla_gate2, b_gla_gate2, gla_out_gain, diff_q_gain, diff_k_gain,
              lam_q1, lam_k1, lam_q2, lam_k2, diff_sub_gain, rel_bias, w_out, norm2_gain,
              w_router, b_router, w_gate_up, b_gate_up, w_down, b_down):
    h = x
    pts = _split_points()
    for l in range(DEPTH):
        lam_init = 0.8 - 0.6 * math.exp(-0.3 * l)
        n = _rmsnorm(h, norm1_gain[l])
        proj = n @ w_in[l]
        gq, gk, gv, glow, gr, dq, dk, dv = jnp.split(proj, pts, axis=-1)
        y_gla = _gla_group(gq, gk, gv, glow, gr, w_gla_gate2[l], b_gla_gate2[l], gla_out_gain[l])
        y_diff = _diff_group(dq, dk, dv, diff_q_gain[l], diff_k_gain[l], lam_q1[l], lam_k1[l],
                             lam_q2[l], lam_k2[l], diff_sub_gain[l], rel_bias, lam_init)
        h = h + jnp.concatenate([y_gla, y_diff], axis=-1) @ w_out[l]
        m = _rmsnorm(h, norm2_gain[l])
        h = h + _moe(m, w_router[l], b_router[l], w_gate_up[l], b_gate_up[l], w_down[l], b_down[l])
    return h
```

```cpp
#include <hip/hip_runtime.h>
#include <cstdio>
#include <cstdint>

#define LAS __attribute__((address_space(3)))
#define GAS __attribute__((address_space(1)))
typedef unsigned short bf16_t;
typedef short bf16x8 __attribute__((ext_vector_type(8)));
typedef short s16x4 __attribute__((ext_vector_type(4)));
typedef float f32x2 __attribute__((ext_vector_type(2)));
typedef float f32x4 __attribute__((ext_vector_type(4)));
typedef float f32x16 __attribute__((ext_vector_type(16)));
typedef unsigned u32x2 __attribute__((ext_vector_type(2)));
typedef unsigned u32x4 __attribute__((ext_vector_type(4)));
typedef __bf16 bf16x2_t __attribute__((ext_vector_type(2)));
typedef GAS unsigned gu32;

constexpr int NB = 8, SEQ = 8192, DM = 1024, T = NB * SEQ;
constexpr int NIN = 3328;
constexpr int NE = 32, TOPK = 4, DFF = 1024;
constexpr int GLA_C = 64, NCH = SEQ / GLA_C;
constexpr float EPS = 1e-6f;
constexpr float LOG2E = 1.4426950408889634f;

constexpr size_t MiB = 1u << 20;
constexpr size_t WS_CTL = 0, CTL_ZERO_BYTES = 1 * MiB;
constexpr size_t WS_DECAY = 1 * MiB;
constexpr size_t WS_WRF = 2 * MiB;
constexpr size_t WS_WIN = 4 * MiB;
constexpr size_t WS_WOUT = 11 * MiB;
constexpr size_t WS_LDST = 13 * MiB;
constexpr size_t WS_LGATE = 21 * MiB;
constexpr size_t WS_WD = 32 * MiB;
constexpr size_t WS_WGU = 96 * MiB;
constexpr size_t WS_XN = 224 * MiB;
constexpr size_t WS_R = 352 * MiB;
constexpr size_t WS_GQ = WS_R, WS_GK = WS_R + 32 * MiB, WS_GV = WS_R + 64 * MiB, WS_GA = WS_R + 128 * MiB, WS_GR = WS_R + 192 * MiB;
constexpr size_t WS_DQ = WS_R + 256 * MiB, WS_DK = WS_R + 320 * MiB, WS_DV = WS_R + 384 * MiB, WS_KVS = WS_R + 448 * MiB;
constexpr size_t WS_HID = WS_R;
constexpr size_t WS_YS0 = WS_WGU, WS_YS1 = WS_XN, WS_YS2 = 864 * MiB;
constexpr size_t WS_END = 993 * MiB;
constexpr int CW_TMO = 0, CW_BAR = 4096, CW_CNT = 16384;

constexpr int LDS_BYTES = 147456;
constexpr int LDS_CTL_OFF = 146432;
constexpr int LDS_TAB_OFF = 131072;

#define LDS_WAIT() asm volatile("s_waitcnt lgkmcnt(0)" ::: "memory")
#define VM_WAIT() asm volatile("s_waitcnt vmcnt(0)" ::: "memory")
#define RLX_AGENT __ATOMIC_RELAXED, __HIP_MEMORY_SCOPE_AGENT

__device__ __forceinline__ unsigned cvtpk(float lo, float hi) { f32x2 v = {lo, hi}; bf16x2_t b = __builtin_convertvector(v, bf16x2_t); return __builtin_bit_cast(unsigned, b); }
__device__ __forceinline__ float bf2f(unsigned short b) { return __uint_as_float((unsigned)b << 16); }
__device__ __forceinline__ float bflo(unsigned w) { return __uint_as_float(w << 16); }
__device__ __forceinline__ float bfhi(unsigned w) { return __uint_as_float(w & 0xffff0000u); }
__device__ __forceinline__ float wave_sum(float v) {
#pragma unroll
    for (int o = 1; o < 64; o <<= 1) v += __shfl_xor(v, o);
    return v;
}
__device__ __forceinline__ int lane_id() { int l; asm volatile("v_mbcnt_lo_u32_b32 %0, -1, 0\n\tv_mbcnt_hi_u32_b32 %0, -1, %0" : "=v"(l)); return l; }
__device__ __forceinline__ float fast_exp2(float x) { return __builtin_amdgcn_exp2f(x); }
__device__ __forceinline__ float fast_rcp(float x) { return __builtin_amdgcn_rcpf(x); }
__device__ __forceinline__ float fast_sigmoid(float x) { return fast_rcp(1.0f + fast_exp2(-x * LOG2E)); }

namespace pg8 {
constexpr int BM = 256, BK = 64, HALF = 128, HTB = HALF * BK * 2, STAGE_BYTES = 8 * HTB, NXCD = 8, WGM = 8;
__host__ __device__ __forceinline__ int lds_byte(int r, int c) { const int st = (r >> 4) * 2 + (c >> 5), rr = r & 15, cc = c & 31, ob = rr * 64 + cc * 2; return st * 1024 + (ob ^ (((ob >> 9) & 1) << 5)); }
__host__ __device__ __forceinline__ void stage_rc(int b, int& R, int& C) { const int st = b / 1024, sb = b % 1024, swz = sb ^ (((sb >> 9) & 1) << 5); R = (st >> 1) * 16 + swz / 64; C = (st & 1) * 32 + (swz % 64) / 2; }
__host__ __device__ __forceinline__ int perm32(int rho) { const int n = rho >> 4, i = rho & 15; return 8 * (i >> 2) + 4 * n + (i & 3); }

struct Unit { int pm, pn, rows, row0, lst, e; };

struct DenseOrder {
    int nM, nN, nwg, G, c; const char* A; const char* Bt; int RB;
    __device__ __forceinline__ void init(const void* A_, const void* Bt_, int M, int N, int K_, int G_, int c_) { A = (const char*)A_; Bt = (const char*)Bt_; RB = K_ * 2; nM = M / BM; nN = N / BM; nwg = nM * nN; G = G_; c = c_; }
    __device__ __forceinline__ bool next(int i, Unit& u) const {
        const long L = (long)i * G + c; if (L >= nwg) return false;
        int wgid = (int)L; { const int q = nwg / NXCD, r = nwg % NXCD, xcd = wgid % NXCD, off = wgid / NXCD; wgid = (xcd < r ? xcd * (q + 1) : r * (q + 1) + (xcd - r) * q) + off; }
        const int nig = WGM * nN, gid = wgid / nig, fm = gid * WGM, gsz = (nM - fm) < WGM ? (nM - fm) : WGM;
        u.pm = fm + ((wgid % nig) % gsz); u.pn = (wgid % nig) / gsz; u.rows = 256; u.row0 = 0; u.lst = 0; u.e = 0; return true;
    }
    __device__ __forceinline__ const char* a_base(const Unit& u) const { return A + (size_t)u.pm * (size_t)BM * RB; }
    __device__ __forceinline__ const char* b_base(const Unit& u) const { return Bt + (size_t)u.pn * (size_t)BM * RB; }
    __device__ __forceinline__ void a_off(const Unit&, const int (&R)[2], const int (&C)[2], unsigned (&o)[2][2]) const {
#pragma unroll
        for (int h = 0; h < 2; ++h)
#pragma unroll
            for (int i = 0; i < 2; ++i) o[h][i] = (unsigned)((h * HALF + R[i]) * RB + C[i] * 2);
    }
};

typedef int v8i32 __attribute__((ext_vector_type(8)));
template <class Epi, class Sched, bool FP8 = false>
__device__ __forceinline__ void gemm_phase(LAS unsigned char* lds, const int RB, const int wid, const Sched& S, const Epi& E) {
    const int lane = lane_id(), tid = wid * 64 + lane, wr = wid >> 2, wc = wid & 3, fr = lane & 15, fq = lane >> 4;
    const int nt = RB / 128;
    int Rr[2], Cc[2]; unsigned voffB[2];
#pragma unroll
    for (int i = 0; i < 2; ++i) { stage_rc(tid * 16 + i * 8192, Rr[i], Cc[i]); const int Rb = Epi::PERM ? ((Rr[i] & ~31) + perm32(Rr[i] & 31)) : Rr[i]; voffB[i] = (unsigned)(Rb * RB + Cc[i] * 2); }
    const size_t kstep = (size_t)(BK * 2);
    const size_t hstep = (size_t)HALF * RB;
    const unsigned ldsw = (unsigned)wid * 1024u;
    const int aoff = lds_byte(wr * 64 + fr, fq * 8), boff = lds_byte(wc * 32 + fr, fq * 8);
#define PG8_SA(b, h) (((b) * 2 + (h)) * HTB)
#define PG8_SB(b, h) ((4 + (b) * 2 + (h)) * HTB)
#define PG8_STAGE(bufoff, gbase, voff) do { _Pragma("unroll") for (int _i = 0; _i < 2; ++_i) { unsigned _o = (voff)[_i]; asm volatile("" : "+v"(_o));     \
        __builtin_amdgcn_global_load_lds((const unsigned*)((const char*)(gbase) + _o), (LAS unsigned*)(lds + (bufoff) + ldsw + _i * 8192), 16, 0, 0); } } while (0)
#define PG8_LDA(dst, b, h) do { _Pragma("unroll") for (int m = 0; m < 4; ++m) _Pragma("unroll") for (int k = 0; k < 2; ++k) dst[m][k] = *(const LAS bf16x8*)(lds + PG8_SA(b, h) + aoff + m * 2048 + k * 1024); } while (0)
#define PG8_LDB(dst, b, h) do { _Pragma("unroll") for (int n = 0; n < 2; ++n) _Pragma("unroll") for (int k = 0; k < 2; ++k) dst[n][k] = *(const LAS bf16x8*)(lds + PG8_SB(b, h) + boff + n * 2048 + k * 1024); } while (0)
#define PG8_CAT(x) __builtin_shufflevector(__builtin_bit_cast(u32x4, (x)[0]), __builtin_bit_cast(u32x4, (x)[1]), 0, 1, 2, 3, 4, 5, 6, 7)
#define PG8_MMA(ai, bj, At, Bt) do { __builtin_amdgcn_s_setprio(1); \
        if constexpr (FP8) { _Pragma("unroll") for (int m = 0; m < 4; ++m) _Pragma("unroll") for (int n = 0; n < 2; ++n) \
            acc[ai][bj][m][n] = __builtin_amdgcn_mfma_scale_f32_16x16x128_f8f6f4(__builtin_bit_cast(v8i32, PG8_CAT(Bt[n])), __builtin_bit_cast(v8i32, PG8_CAT(At[m])), acc[ai][bj][m][n], 0, 0, 0, 0x7f7f7f7f, 0, 0x7f7f7f7f); } \
        else { _Pragma("unroll") for (int m = 0; m < 4; ++m) _Pragma("unroll") for (int n = 0; n < 2; ++n) _Pragma("unroll") for (int k = 0; k < 2; ++k) \
            acc[ai][bj][m][n] = __builtin_amdgcn_mfma_f32_16x16x32_bf16(Bt[n][k], At[m][k], acc[ai][bj][m][n], 0, 0, 0); } \
        __builtin_amdgcn_s_setprio(0); } while (0)
#define PG8_WAIT_V(n) asm volatile("s_waitcnt vmcnt(" #n ")" ::: "memory")
#define PG8_WAIT_L(n) asm volatile("s_waitcnt lgkmcnt(" #n ")" ::: "memory")
#define PG8_BAR __builtin_amdgcn_s_barrier()
#define PG8_SCHED __builtin_amdgcn_sched_barrier(0)
    Unit cur, nxt; int ui = 0;
    if (!S.next(0, cur)) return;
    f32x4 acc[2][2][4][2];
#pragma unroll
    for (int a = 0; a < 2; ++a)
#pragma unroll
        for (int b = 0; b < 2; ++b)
#pragma unroll
            for (int m = 0; m < 4; ++m)
#pragma unroll
                for (int n = 0; n < 2; ++n) acc[a][b][m][n] = (f32x4){0.f, 0.f, 0.f, 0.f};
    bf16x8 At[4][2], B0[2][2], B1[2][2];
    const char* cA = S.a_base(cur); const char* cB = S.b_base(cur);
    unsigned vA[2][2], nvA[2][2];
    S.a_off(cur, Rr, Cc, vA);
    PG8_STAGE(PG8_SB(0, 0), cB, voffB); PG8_STAGE(PG8_SB(0, 1), cB + hstep, voffB); PG8_STAGE(PG8_SA(0, 0), cA, vA[0]); PG8_STAGE(PG8_SA(0, 1), cA, vA[1]);
    if (wr == 1) PG8_BAR;
    PG8_WAIT_V(2); PG8_BAR;
    PG8_STAGE(PG8_SB(1, 0), cB + kstep, voffB); PG8_STAGE(PG8_SA(1, 0), cA + kstep, vA[0]); PG8_STAGE(PG8_SB(1, 1), cB + hstep + kstep, voffB);
    PG8_WAIT_V(6); PG8_BAR;
    for (;;) {
        const bool has_next = S.next(ui + 1, nxt);
        const char* nA = cA; const char* nB = cB;
#pragma unroll
        for (int h = 0; h < 2; ++h)
#pragma unroll
            for (int i = 0; i < 2; ++i) nvA[h][i] = vA[h][i];
        if (has_next) { nA = S.a_base(nxt); nB = S.b_base(nxt); S.a_off(nxt, Rr, Cc, nvA); }
#pragma unroll 1
        for (int t = 0; t < nt; t += 2) {
            const bool last = (t == nt - 2);
            const char* a1 = cA + (size_t)(t + 1) * kstep;
            const char* a2 = last ? nA : cA + (size_t)(t + 2) * kstep; const char* b2 = last ? nB : cB + (size_t)(t + 2) * kstep;
            const char* a3 = a2 + kstep; const char* b3 = b2 + kstep;
            PG8_LDB(B0, 0, 0); PG8_LDB(B1, 0, 1); PG8_SCHED; PG8_LDA(At, 0, 0); PG8_STAGE(PG8_SA(1, 1), a1, vA[1]);
            if (last) {
#pragma unroll
                for (int h = 0; h < 2; ++h)
#pragma unroll
                    for (int i = 0; i < 2; ++i) vA[h][i] = nvA[h][i]; }
            PG8_WAIT_V(8); PG8_WAIT_L(0); PG8_BAR; PG8_MMA(0, 0, At, B0); PG8_MMA(0, 1, At, B1); PG8_BAR; PG8_SCHED;
            PG8_LDA(At, 0, 1); PG8_STAGE(PG8_SB(0, 0), b2, voffB); PG8_STAGE(PG8_SB(0, 1), b2 + hstep, voffB); PG8_STAGE(PG8_SA(0, 0), a2, vA[0]);
            PG8_WAIT_V(8); PG8_WAIT_L(0); PG8_BAR; PG8_MMA(1, 0, At, B0); PG8_MMA(1, 1, At, B1); PG8_BAR; PG8_SCHED;
            PG8_LDB(B0, 1, 0); PG8_LDB(B1, 1, 1); PG8_SCHED; PG8_LDA(At, 1, 0); PG8_STAGE(PG8_SA(0, 1), a2, vA[1]);
            PG8_WAIT_V(8); PG8_WAIT_L(0); PG8_BAR; PG8_MMA(0, 0, At, B0); PG8_MMA(0, 1, At, B1); PG8_BAR; PG8_SCHED;
            PG8_LDA(At, 1, 1); PG8_STAGE(PG8_SB(1, 0), b3, voffB); PG8_STAGE(PG8_SB(1, 1), b3 + hstep, voffB); PG8_STAGE(PG8_SA(1, 0), a3, vA[0]);
            PG8_WAIT_V(8); PG8_WAIT_L(0); PG8_BAR; PG8_MMA(1, 0, At, B0); PG8_MMA(1, 1, At, B1); PG8_BAR; PG8_SCHED;
        }
        if (wr == 0) PG8_BAR;
        E(acc, cur, wr, wc, fr, fq);
        if (!has_next) break;
#pragma unroll
        for (int a = 0; a < 2; ++a)
#pragma unroll
            for (int b = 0; b < 2; ++b)
#pragma unroll
                for (int m = 0; m < 4; ++m)
#pragma unroll
                    for (int n = 0; n < 2; ++n) acc[a][b][m][n] = (f32x4){0.f, 0.f, 0.f, 0.f};
        cur = nxt; cA = nA; cB = nB; ++ui;
#pragma unroll
        for (int h = 0; h < 2; ++h)
#pragma unroll
            for (int i = 0; i < 2; ++i) vA[h][i] = nvA[h][i];
        if (wr == 1) PG8_BAR;
    }
    PG8_WAIT_V(0);
    PG8_BAR;
#undef PG8_SA
#undef PG8_SB
#undef PG8_STAGE
#undef PG8_LDA
#undef PG8_LDB
#undef PG8_MMA
#undef PG8_CAT
#undef PG8_WAIT_V
#undef PG8_WAIT_L
#undef PG8_BAR
#undef PG8_SCHED
}
}
typedef pg8::Unit Unit;
#define EPI_ROWS(ai, m) (128 * (ai) + 64 * wr + 16 * (m) + fr)

constexpr float WSCALE = 64.f, WSCALE_INV = 1.f / 64.f;
__device__ __forceinline__ unsigned pk4_fp8(float a, float b, float c, float d) { unsigned w = 0u; w = __builtin_amdgcn_cvt_pk_fp8_f32(a, b, w, false); w = __builtin_amdgcn_cvt_pk_fp8_f32(c, d, w, true); return w; }
__device__ __forceinline__ u32x4 pack8(const f32x4& a, const f32x4& b) { u32x4 w; w.x = cvtpk(a[0], a[1]); w.y = cvtpk(a[2], a[3]); w.z = cvtpk(b[0], b[1]); w.w = cvtpk(b[2], b[3]); return w; }

struct EpiInProj {
    static constexpr bool PERM = true;
    unsigned char* ws; const float* bgate; const float* qgain; const float* kgain;
    __device__ __forceinline__ void operator()(const f32x4 (&acc)[2][2][4][2], const Unit& u, int wr, int wc, int fr, int fq) const {
        const int tile = u.pn; const size_t row0 = (size_t)u.pm * 256;
        if (tile == 4) {
            float* GA = (float*)(ws + WS_GA);
#pragma unroll
            for (int bj = 0; bj < 2; ++bj) { const int col = 128 * bj + 32 * wc + 8 * fq;
                const f32x4 b0 = *(const f32x4*)(bgate + col), b1 = *(const f32x4*)(bgate + col + 4);
#pragma unroll
                for (int ai = 0; ai < 2; ++ai)
#pragma unroll
                    for (int m = 0; m < 4; ++m) { f32x4 v0 = acc[ai][bj][m][0] + b0, v1 = acc[ai][bj][m][1] + b1;
#pragma unroll
                        for (int i = 0; i < 4; ++i) { v0[i] = (fminf(v0[i], 0.f) - __logf(1.f + __expf(-fabsf(v0[i])))) * 0.0625f; v1[i] = (fminf(v1[i], 0.f) - __logf(1.f + __expf(-fabsf(v1[i])))) * 0.0625f; }
                        float* p = GA + (row0 + EPI_ROWS(ai, m)) * 256 + col; *(f32x4*)p = v0; *(f32x4*)(p + 4) = v1; } }
        } else if (tile >= 7 && tile <= 10) {
            const bool isq = tile <= 8; const float* gn = isq ? qgain : kgain; const float osc = isq ? 0.125f * LOG2E : 1.0f;
            bf16_t* O = (bf16_t*)(ws + (isq ? WS_DQ : WS_DK)); const int tl = (tile - 7) & 1;
            f32x4 g[2][2];
#pragma unroll
            for (int bj = 0; bj < 2; ++bj)
#pragma unroll
                for (int n = 0; n < 2; ++n) g[bj][n] = *(const f32x4*)(gn + 32 * bj + 8 * fq + 4 * n) * osc;
#pragma unroll
            for (int ai = 0; ai < 2; ++ai)
#pragma unroll
                for (int m = 0; m < 4; ++m) { float ss = 0.f;
#pragma unroll
                    for (int bj = 0; bj < 2; ++bj)
#pragma unroll
                        for (int n = 0; n < 2; ++n) { const f32x4 x = acc[ai][bj][m][n]; ss += (x[0] * x[0] + x[1] * x[1]) + (x[2] * x[2] + x[3] * x[3]); }
                    ss += __shfl_xor(ss, 16); ss += __shfl_xor(ss, 32);
                    const float rs = __builtin_amdgcn_rsqf(ss * (1.f / 64.f) + EPS);
                    bf16_t* p = O + (row0 + EPI_ROWS(ai, m)) * 512 + tl * 256 + 64 * wc + 8 * fq;
#pragma unroll
                    for (int bj = 0; bj < 2; ++bj) *(u32x4*)(p + 32 * bj) = pack8(acc[ai][bj][m][0] * rs * g[bj][0], acc[ai][bj][m][1] * rs * g[bj][1]); }
        } else {
            size_t base; int ld, c0; float sc = 1.f; bool silu = false;
            if (tile == 0) { base = WS_GQ; ld = 256; c0 = 0; sc = 0.125f; }
            else if (tile == 1) { base = WS_GK; ld = 256; c0 = 0; }
            else if (tile <= 3) { base = WS_GV; ld = 512; c0 = (tile - 2) * 256; }
            else if (tile <= 6) { base = WS_GR; ld = 512; c0 = (tile - 5) * 256; silu = true; }
            else { base = WS_DV; ld = 512; c0 = (tile - 11) * 256; }
            bf16_t* O = (bf16_t*)(ws + base);
#pragma unroll
            for (int ai = 0; ai < 2; ++ai)
#pragma unroll
                for (int m = 0; m < 4; ++m) { bf16_t* p = O + (row0 + EPI_ROWS(ai, m)) * ld + c0 + 32 * wc + 8 * fq;
#pragma unroll
                    for (int bj = 0; bj < 2; ++bj) { f32x4 v0 = acc[ai][bj][m][0] * sc, v1 = acc[ai][bj][m][1] * sc;
                        if (silu) {
#pragma unroll
                            for (int i = 0; i < 4; ++i) { v0[i] = v0[i] * fast_sigmoid(v0[i]); v1[i] = v1[i] * fast_sigmoid(v1[i]); } }
                        *(u32x4*)(p + 128 * bj) = pack8(v0, v1); } }
        }
    }
};

struct EpiResid {
    static constexpr bool PERM = true;
    const float* x; float* out;
    __device__ __forceinline__ void operator()(const f32x4 (&acc)[2][2][4][2], const Unit& u, int wr, int wc, int fr, int fq) const {
#pragma unroll
        for (int ai = 0; ai < 2; ++ai)
#pragma unroll
            for (int m = 0; m < 4; ++m) { const size_t off = ((size_t)u.pm * 256 + EPI_ROWS(ai, m)) * DM + (size_t)u.pn * 256 + 32 * wc + 8 * fq;
#pragma unroll
                for (int bj = 0; bj < 2; ++bj) { const float* xp = x + off + 128 * bj; float* op = out + off + 128 * bj;
                    const f32x4 x0 = *(const f32x4*)xp, x1 = *(const f32x4*)(xp + 4);
                    *(f32x4*)op = x0 + acc[ai][bj][m][0]; *(f32x4*)(op + 4) = x1 + acc[ai][bj][m][1]; } }
    }
};

struct EpiGateUp {
    static constexpr bool PERM = true;
    unsigned char* hid; const float* bgu;
    __device__ __forceinline__ void operator()(const f32x4 (&acc)[2][2][4][2], const Unit& u, int wr, int wc, int fr, int fq) const {
        asm volatile("" : "+v"(fr), "+v"(fq));
        const int nt = u.pn & 7, hc = nt * 128 + 32 * wc + 8 * fq;
        const float* bp = bgu + (size_t)u.e * 2048 + hc;
        const f32x4 bg0 = *(const f32x4*)bp, bg1 = *(const f32x4*)(bp + 4), bl0 = *(const f32x4*)(bp + 1024), bl1 = *(const f32x4*)(bp + 1028);
#pragma unroll
        for (int ai = 0; ai < 2; ++ai)
#pragma unroll
            for (int m = 0; m < 4; ++m) { const int rl = EPI_ROWS(ai, m);
                f32x4 g0 = acc[ai][0][m][0] * WSCALE_INV + bg0, g1 = acc[ai][0][m][1] * WSCALE_INV + bg1, l0 = acc[ai][1][m][0] * WSCALE_INV + bl0, l1 = acc[ai][1][m][1] * WSCALE_INV + bl1;
#pragma unroll
                for (int i = 0; i < 4; ++i) {
                    const float a = fminf(g0[i], 7.f), b = fminf(g1[i], 7.f);
                    g0[i] = a * fast_sigmoid(1.702f * a) * (fminf(fmaxf(l0[i], -7.f), 7.f) + 1.f);
                    g1[i] = b * fast_sigmoid(1.702f * b) * (fminf(fmaxf(l1[i], -7.f), 7.f) + 1.f); }
                if (rl < u.rows) { u32x2 w; w.x = pk4_fp8(g0[0], g0[1], g0[2], g0[3]); w.y = pk4_fp8(g1[0], g1[1], g1[2], g1[3]); *(u32x2*)(hid + ((size_t)u.row0 + rl) * DFF + hc) = w; } }
    }
};

struct EpiDown {
    static constexpr bool PERM = true;
    unsigned char* ws; float* out; const float* bd;
    __device__ __forceinline__ void operator()(const f32x4 (&acc)[2][2][4][2], const Unit& u, int wr, int wc, int fr, int fq) const {
        asm volatile("" : "+v"(fr), "+v"(fq));
        const int nt = u.pn & 3; const int* ldst = (const int*)(ws + WS_LDST) + u.lst; const float* lg = (const float*)(ws + WS_LGATE) + u.lst;
#pragma unroll
        for (int bj = 0; bj < 2; ++bj) { const size_t col = (size_t)nt * 256 + 128 * bj + 32 * wc + 8 * fq;
            const float* bp = bd + (size_t)u.e * 1024 + col; f32x4 b0 = *(const f32x4*)bp, b1 = *(const f32x4*)(bp + 4);
            asm volatile("" : "+v"(b0), "+v"(b1));
#pragma unroll
            for (int ai = 0; ai < 2; ++ai)
#pragma unroll
                for (int m = 0; m < 4; ++m) { const int rl = EPI_ROWS(ai, m);
                    if (rl < u.rows) { const int dst = ldst[rl]; const float gt = lg[rl]; const int tok = dst >> 2, k = dst & 3;
                        const f32x4 y0 = (acc[ai][bj][m][0] * WSCALE_INV + b0) * gt, y1 = (acc[ai][bj][m][1] * WSCALE_INV + b1) * gt;
                        if (k == 3) { float* op = out + (size_t)tok * DM + col; f32x4 o0 = *(const f32x4*)op, o1 = *(const f32x4*)(op + 4); o0 += y0; o1 += y1; *(f32x4*)op = o0; *(f32x4*)(op + 4) = o1; }
                        else { bf16_t* yp = (bf16_t*)(ws + (k == 0 ? WS_YS0 : (k == 1 ? WS_YS1 : WS_YS2))) + (size_t)tok * DM + col; *(u32x4*)yp = pack8(y0, y1); } } }
        }
    }
};

struct MoeOrder {
    const LAS int* tab;
    int G, c, NT, gather;
    const char* A; const char* Bt; const int* ldst;
    __device__ __forceinline__ int rd(int i) const { return __builtin_amdgcn_readfirstlane(tab[i]); }
    __device__ __forceinline__ bool next(int i, Unit& u) const {
        const int g = i * G + c, MT = rd(32);
        if (g >= MT * NT) return false;
        const int mtg = g / NT, nt = g - mtg * NT;
        int e = 0;
#pragma unroll 1
        for (int s = 16; s >= 1; s >>= 1) if (rd(e + s) <= mtg) e += s;
        const int mt = mtg - rd(e), cnt = rd(80 + e);
        u.e = e; u.pm = mt; u.pn = e * NT + nt; u.rows = min(256, cnt - mt * 256); u.row0 = rd(40 + e) + mt * 256; u.lst = e * 65536 + mt * 256;
        return true;
    }
    __device__ __forceinline__ const char* a_base(const Unit& u) const { return gather ? A : A + (size_t)u.row0 * (size_t)DM; }
    __device__ __forceinline__ const char* b_base(const Unit& u) const { return Bt + (size_t)u.pn * (size_t)256 * DM; }
    __device__ __forceinline__ void a_off(const Unit& u, const int (&R)[2], const int (&C)[2], unsigned (&o)[2][2]) const {
#pragma unroll
        for (int h = 0; h < 2; ++h)
#pragma unroll
            for (int i = 0; i < 2; ++i) { const int rl = h * 128 + R[i];
                if (gather) { const int tok = ldst[u.lst + (rl < u.rows ? rl : 0)] >> 2; o[h][i] = (unsigned)(tok * DM + C[i] * 2); }
                else o[h][i] = (unsigned)(rl * DM + C[i] * 2); }
        if (gather) {
#pragma unroll
            for (int h = 0; h < 2; ++h)
#pragma unroll
                for (int i = 0; i < 2; ++i) asm volatile("" : "+v"(o[h][i])); }
    }
};
#define XB_TMO      128
#define XB_XCNT(j)  (256  + 64 * (j))
#define XB_XSUB(j)  (1280 + 64 * (j))
#define XB_XGEN(j)  (2304 + 64 * (j))
#define XB_TOP      3328
#define XB_TOPGEN   3392
#define XCD_BAR_WORDS 3456
#define XB_SPIN_CAP (1u << 18)

__device__ __forceinline__ unsigned xb_ld(unsigned* p)              { return __hip_atomic_load(p, __ATOMIC_RELAXED, __HIP_MEMORY_SCOPE_AGENT); }
__device__ __forceinline__ unsigned xb_add(unsigned* p, unsigned v) { return __hip_atomic_fetch_add(p, v, __ATOMIC_RELAXED, __HIP_MEMORY_SCOPE_AGENT); }
__device__ __forceinline__ unsigned xb_xcc_id() { return (unsigned)__builtin_amdgcn_s_getreg((3 << 11) | 20) & 0xFu; }
#define XB_SPIN(cond, bar) do { unsigned _sp = 0; while (cond) { __builtin_amdgcn_s_sleep(1); \
    if ((++_sp & 255u) == 0u) { if (xb_ld(&(bar)[XB_TMO])) break; if (_sp > XB_SPIN_CAP) { atomicAdd(&(bar)[XB_TMO], 1u); break; } } } } while (0)

struct XcdBarrier {
    unsigned* bar; unsigned x; int wave;
    volatile LAS unsigned* st;
};

__device__ __forceinline__ XcdBarrier xcd_barrier_post(unsigned* bar, volatile LAS unsigned* st, int wave) {
    XcdBarrier b; b.bar = bar; b.x = xb_xcc_id(); b.st = st; b.wave = wave;
    if (wave == 0 && lane_id() == 0) (void)xb_add(&bar[XB_XCNT(b.x)], 1u);
    return b;
}
__device__ __forceinline__ void xcd_barrier_complete(unsigned* bar, unsigned x, unsigned& nloc, unsigned& nx) {
    const unsigned G = gridDim.x * gridDim.y * gridDim.z;
    unsigned sum, cnt, mine, sp = 0u;
    for (;;) {
        sum = 0u; cnt = 0u; mine = 0u;
#pragma unroll
        for (unsigned j = 0; j < 16; ++j) { const unsigned c = xb_ld(&bar[XB_XCNT(j)]); sum += c; cnt += (c > 0u) ? 1u : 0u; mine = (j == x) ? c : mine; }
        if (sum == G) break;
        __builtin_amdgcn_s_sleep(1);
        if ((++sp & 255u) == 0u) { if (xb_ld(&bar[XB_TMO])) break; if (sp > XB_SPIN_CAP) { atomicAdd(&bar[XB_TMO], 1u); break; } }
    }
    nloc = mine > 0u ? mine : 1u; nx = cnt > 0u ? cnt : 1u;
}

__device__ __forceinline__ void xcd_barrier(const XcdBarrier& b) {
    asm volatile("s_waitcnt vmcnt(0)" ::: "memory");
    __syncthreads();
    if (b.wave == 0 && lane_id() == 0) {
        unsigned* bar = b.bar;
        __builtin_amdgcn_s_waitcnt(0);
        unsigned nloc = b.st[0], nx = b.st[1];
        if (nloc == 0u) { xcd_barrier_complete(bar, b.x, nloc, nx); b.st[0] = nloc; b.st[1] = nx; }
        const unsigned old = xb_add(&bar[XB_XSUB(b.x)], 1u);
        const unsigned gen = old / nloc;
        if (old + 1u == (gen + 1u) * nloc) {
            __builtin_amdgcn_fence(__ATOMIC_RELEASE, "agent");
            asm volatile("s_waitcnt vmcnt(0)" ::: "memory");
            const unsigned og = xb_add(&bar[XB_TOP], 1u);
            const unsigned tg = og / nx;
            if (og + 1u == (tg + 1u) * nx) xb_add(&bar[XB_TOPGEN], 1u);
            else XB_SPIN(xb_ld(&bar[XB_TOPGEN]) == tg, bar);
            __builtin_amdgcn_fence(__ATOMIC_ACQUIRE, "agent");
            xb_add(&bar[XB_XGEN(b.x)], 1u);
            asm volatile("s_waitcnt vmcnt(0)" ::: "memory");
        } else {
            XB_SPIN(xb_ld(&bar[XB_XGEN(b.x)]) == gen, bar);
            __builtin_amdgcn_fence(__ATOMIC_ACQUIRE, "agent");
            asm volatile("s_waitcnt vmcnt(0)" ::: "memory");
        }
    }
    __syncthreads();
}
struct Frame {
    LAS unsigned char* lds;
    gu32* ctl;
    int wave, vcu, G;
    const float* in[22]; float* out; unsigned char* ws;
};
enum { I_X = 0, I_N1G, I_WIN, I_WG2, I_BG2, I_GOG, I_QG, I_KG, I_LQ1, I_LK1, I_LQ2, I_LK2, I_SUBG, I_RELB, I_WOUT, I_N2G, I_WR, I_BR, I_WGU, I_BGU, I_WD, I_BD };

__device__ __forceinline__ s16x4 tr4(const LAS unsigned char* p) { return __builtin_bit_cast(s16x4, __builtin_amdgcn_ds_read_tr16_b64_v4i16((LAS s16x4*)p)); }
__device__ __forceinline__ bf16x8 cat8(s16x4 lo, s16x4 hi) { return __builtin_shufflevector(lo, hi, 0, 1, 2, 3, 4, 5, 6, 7); }
__device__ __forceinline__ int crow(int r, int hi) { return (r & 3) + 8 * (r >> 2) + 4 * hi; }
#define MFMA32(a, b, c) __builtin_amdgcn_mfma_f32_32x32x16_bf16((a), (b), (c), 0, 0, 0)
__device__ __forceinline__ float swap32(float v) { return __shfl_xor(v, 32); }
__device__ __forceinline__ bf16x8 pack_step(const f32x16& x, int s) {
    u32x4 p; p.x = cvtpk(x[8 * s], x[8 * s + 1]); p.y = cvtpk(x[8 * s + 2], x[8 * s + 3]); p.z = cvtpk(x[8 * s + 4], x[8 * s + 5]); p.w = cvtpk(x[8 * s + 6], x[8 * s + 7]);
    return __builtin_bit_cast(bf16x8, p);
}

__device__ __forceinline__ void p0_tr64(const float* W, int ldw, int ca, int cb, int k0, bf16_t* WT, size_t dst_row0, LAS float* scr, int lane) {
    const int sc = (lane & 32) ? cb + (lane & 31) : ca + (lane & 31);
    const float* src = W + (size_t)k0 * ldw + sc;
#pragma unroll 16
    for (int i = 0; i < 64; ++i) scr[i * 65 + lane] = src[(size_t)i * ldw];
    LDS_WAIT();
    const int c = lane & 7;
#pragma unroll
    for (int j = 0; j < 8; ++j) { const int n = (lane >> 3) + 8 * j; const LAS float* s = scr + (8 * c) * 65 + n;
        u32x4 o; o.x = cvtpk(s[0], s[65]); o.y = cvtpk(s[130], s[195]); o.z = cvtpk(s[260], s[325]); o.w = cvtpk(s[390], s[455]);
        *(u32x4*)(WT + (dst_row0 + n) * 1024 + k0 + 8 * c) = o; }
    LDS_WAIT();
}
__device__ __forceinline__ void p0_tr64_fp8(const float* W, int ldw, int ca, int k0, unsigned char* WT, size_t dst_row0, LAS float* scr, int lane) {
    const float* src = W + (size_t)k0 * ldw + ca + lane;
#pragma unroll 16
    for (int i = 0; i < 64; ++i) scr[i * 65 + lane] = src[(size_t)i * ldw];
    LDS_WAIT();
    const int c = lane & 3;
#pragma unroll
    for (int j = 0; j < 4; ++j) { const int n = (lane >> 2) + 16 * j; const LAS float* s = scr + (16 * c) * 65 + n;
        u32x4 o;
        o.x = pk4_fp8(s[0] * WSCALE, s[65] * WSCALE, s[130] * WSCALE, s[195] * WSCALE); o.y = pk4_fp8(s[260] * WSCALE, s[325] * WSCALE, s[390] * WSCALE, s[455] * WSCALE);
        o.z = pk4_fp8(s[520] * WSCALE, s[585] * WSCALE, s[650] * WSCALE, s[715] * WSCALE); o.w = pk4_fp8(s[780] * WSCALE, s[845] * WSCALE, s[910] * WSCALE, s[975] * WSCALE);
        *(u32x4*)(WT + (dst_row0 + n) * 1024 + k0 + 16 * c) = o; }
    LDS_WAIT();
}
__device__ __forceinline__ int src32_qk(int d) { return 2 * (d & 3) + (d >> 2); }
__device__ __forceinline__ void p0_prologue(Frame& F) {
    LAS float* scr = (LAS float*)(F.lds + F.wave * 16640);
    const int gw = F.vcu * 8 + F.wave, NGW = F.G * 8;
    constexpr int I_A = 48 * 16, I_B = 16 * 16, I_C = 32 * 32 * 16, I_D = 32 * 16 * 16, NITEMS = I_A + I_B + I_C + I_D;
    bf16_t* WinT = (bf16_t*)(F.ws + WS_WIN); bf16_t* WoutT = (bf16_t*)(F.ws + WS_WOUT); unsigned char* WguT = F.ws + WS_WGU; unsigned char* WdT = F.ws + WS_WD;
    for (int it = gw; it < NITEMS; it += NGW) {
        int r = it;
        if (r < I_A) { const int kb = r & 15, idx = r >> 4, dg = idx < 16 ? idx : idx + 4; int ca, cb;
            if (dg < 16) { ca = 64 * dg; cb = ca + 32; }
            else if (dg < 28) { ca = 1040 + 64 * (dg - 20); cb = ca + 32; }
            else if (dg < 44) { const int tl = (dg - 28) >> 2, up = (dg - 28) & 3, base = tl < 2 ? 1552 + 256 * tl : 2064 + 256 * (tl - 2); ca = base + 32 * src32_qk(2 * up); cb = base + 32 * src32_qk(2 * up + 1); }
            else { ca = 2576 + 64 * (dg - 44); cb = ca + 32; }
            p0_tr64(F.in[I_WIN], 3088, ca, cb, 64 * kb, WinT, (size_t)64 * dg, scr, lane_id()); continue; }
        r -= I_A;
        if (r < I_B) { const int kb = r & 15, g = r >> 4; p0_tr64(F.in[I_WOUT], 1024, 64 * g, 64 * g + 32, 64 * kb, WoutT, (size_t)64 * g, scr, lane_id()); continue; }
        r -= I_B;
        if (r < I_C) { const int kb = r & 15, grp = (r >> 4) & 31, e = r >> 9, nt = grp >> 2, bj = (grp >> 1) & 1, hf = grp & 1, ca = bj * 1024 + nt * 128 + 64 * hf;
            p0_tr64_fp8(F.in[I_WGU] + (size_t)e * 1024 * 2048, 2048, ca, 64 * kb, WguT, (size_t)e * 2048 + 64 * grp, scr, lane_id()); continue; }
        r -= I_C;
        { const int kb = r & 15, g = (r >> 4) & 15, e = r >> 8; p0_tr64_fp8(F.in[I_WD] + (size_t)e * 1024 * 1024, 1024, 64 * g, 64 * kb, WdT, (size_t)e * 1024 + 64 * g, scr, lane_id()); }
    }
    { const int gt = F.vcu * 512 + (F.wave * 64 + lane_id()), NT_ = F.G * 512; const float* w2 = F.in[I_WG2]; const float* win = F.in[I_WIN];
        for (int idx = gt; idx < 256 * 128; idx += NT_) { const int n = idx & 255, kg = idx >> 8; float wv[16];
#pragma unroll
            for (int r = 0; r < 16; ++r) wv[r] = w2[r * 256 + n];
            float o[8];
#pragma unroll
            for (int kk = 0; kk < 8; ++kk) { const float* wp = win + (size_t)(8 * kg + kk) * 3088 + 1024; float a = 0.f;
#pragma unroll
                for (int r = 0; r < 16; ++r) a += wv[r] * wp[r];
                o[kk] = a; }
            u32x4 w; w.x = cvtpk(o[0], o[1]); w.y = cvtpk(o[2], o[3]); w.z = cvtpk(o[4], o[5]); w.w = cvtpk(o[6], o[7]);
            *(u32x4*)(WinT + (size_t)(1024 + n) * 1024 + 8 * kg) = w; }
        const float* wr_ = F.in[I_WR]; bf16_t* wrf = (bf16_t*)(F.ws + WS_WRF);
        for (int idx = gt; idx < 64 * 64; idx += NT_) { const int ks = idx >> 6, ln = idx & 63, e = ln & 31, hh = ln >> 5; float o[8];
#pragma unroll
            for (int j = 0; j < 8; ++j) o[j] = wr_[(16 * ks + 8 * hh + j) * 32 + e];
            u32x4 w; w.x = cvtpk(o[0], o[1]); w.y = cvtpk(o[2], o[3]); w.z = cvtpk(o[4], o[5]); w.w = cvtpk(o[6], o[7]);
            *(u32x4*)(wrf + (size_t)idx * 8) = w; }
    }
    { const float* x = F.in[I_X]; const float* gn = F.in[I_N1G]; bf16_t* XN = (bf16_t*)(F.ws + WS_XN);
        f32x4 g[4];
#pragma unroll
        for (int j = 0; j < 4; ++j) g[j] = *(const f32x4*)(gn + 4 * lane_id() + 256 * j);
        for (int m = gw; m < T; m += NGW) { const f32x4* xr = (const f32x4*)(x + (size_t)m * DM) + lane_id(); f32x4 v[4]; float s = 0.f;
#pragma unroll
            for (int j = 0; j < 4; ++j) { v[j] = xr[64 * j]; s += (v[j].x * v[j].x + v[j].y * v[j].y) + (v[j].z * v[j].z + v[j].w * v[j].w); }
            const float rs = __builtin_amdgcn_rsqf(wave_sum(s) * (1.f / DM) + EPS);
            u32x2* o8 = (u32x2*)(XN + (size_t)m * DM) + lane_id();
#pragma unroll
            for (int j = 0; j < 4; ++j) { const f32x4 y = v[j] * rs * g[j]; u32x2 w; w.x = cvtpk(y.x, y.y); w.y = cvtpk(y.z, y.w); o8[64 * j] = w; } }
    }
}

__device__ __forceinline__ void gla_g01(Frame& F) {
    LAS unsigned char* L = F.lds;
    LAS float* LA = (LAS float*)L; LAS float* PART = (LAS float*)(L + 16384); LAS unsigned char* KR = L + 18432; LAS unsigned char* VL = L + 27136;
    const float* GA = (const float*)(F.ws + WS_GA); bf16_t* GQ = (bf16_t*)(F.ws + WS_GQ); bf16_t* GK = (bf16_t*)(F.ws + WS_GK); const bf16_t* GV = (const bf16_t*)(F.ws + WS_GV);
    bf16_t* KVS = (bf16_t*)(F.ws + WS_KVS); float* DEC = (float*)(F.ws + WS_DECAY);
    const int tid = (F.wave * 64 + lane_id()), lane = lane_id(), w = F.wave;
    for (int u = F.vcu; u < 4096; u += F.G) {
        const int n = u & 127, bh = u >> 7, h = bh & 3, b = bh >> 2; const size_t row0 = (size_t)b * SEQ + 64 * n;
#pragma unroll
        for (int p = 0; p < 2; ++p) { const int idx = tid + 512 * p, t = idx >> 4, c = idx & 15;
            *(LAS f32x4*)(LA + t * 64 + 4 * c) = *(const f32x4*)(GA + (row0 + t) * 256 + h * 64 + 4 * c);
            *(LAS u32x4*)(VL + t * 272 + 16 * c) = *(const u32x4*)(GV + (row0 + t) * 512 + h * 128 + 8 * c); }
        __syncthreads();
        const int d = tid & 63, part = tid >> 6; float cs[8]; float run = 0.f;
#pragma unroll
        for (int i = 0; i < 8; ++i) { run += LA[(8 * part + i) * 64 + d]; cs[i] = run; }
        PART[part * 64 + d] = run;
        __syncthreads();
        float offs = 0.f, tot = 0.f;
#pragma unroll
        for (int p = 0; p < 8; ++p) { const float v = PART[p * 64 + d]; tot += v; if (p < part) offs += v; }
#pragma unroll
        for (int i = 0; i < 8; ++i) { const int t = 8 * part + i; const float bb = offs + cs[i]; const size_t gi = (row0 + t) * 256 + h * 64 + d;
            const float q = bf2f(GQ[gi]), k = bf2f(GK[gi]);
            const float eb = __expf(bb), kd = k * __expf(-bb), kr = k * __expf(tot - bb);
            GQ[gi] = (bf16_t)(cvtpk(q * eb, 0.f) & 0xffffu); GK[gi] = (bf16_t)(cvtpk(kd, 0.f) & 0xffffu);
            *(LAS bf16_t*)(KR + t * 136 + 2 * d) = (bf16_t)(cvtpk(kr, 0.f) & 0xffffu); }
        if (part == 0) DEC[(size_t)u * 64 + d] = __expf(tot);
        __syncthreads();
        { const int db = w & 1, eb = w >> 1, hh = lane >> 5, blk = (lane >> 4) & 1, q4 = (lane & 15) >> 2, p4 = lane & 3;
            f32x16 acc; for (int i = 0; i < 16; ++i) acc[i] = 0.f;
#pragma unroll
            for (int ks = 0; ks < 4; ++ks) { const int r0 = 16 * ks + 8 * hh + q4;
                const bf16x8 a = cat8(tr4(KR + r0 * 136 + (32 * db + 16 * blk + 4 * p4) * 2), tr4(KR + (r0 + 4) * 136 + (32 * db + 16 * blk + 4 * p4) * 2));
                const bf16x8 bb = cat8(tr4(VL + r0 * 272 + (32 * eb + 16 * blk + 4 * p4) * 2), tr4(VL + (r0 + 4) * 272 + (32 * eb + 16 * blk + 4 * p4) * 2));
                acc = MFMA32(a, bb, acc); }
            bf16_t* o = KVS + ((size_t)u * 64 + 32 * db) * 128 + 32 * eb + (lane & 31);
#pragma unroll
            for (int i = 0; i < 16; ++i) o[(size_t)crow(i, hh) * 128] = (bf16_t)(cvtpk(acc[i], 0.f) & 0xffffu); }
        __syncthreads();
    }
}
__device__ __forceinline__ void gla_scan(Frame& F) {
    unsigned* KVS = (unsigned*)(F.ws + WS_KVS); const float* DEC = (const float*)(F.ws + WS_DECAY);
    for (int g = F.vcu * 512 + (F.wave * 64 + lane_id()); g < 32 * 64 * 64; g += F.G * 512) { const int e2 = g & 63, d = (g >> 6) & 63, bh = g >> 12;
        float s0 = 0.f, s1 = 0.f;
        for (int n0 = 0; n0 < 128; n0 += 8) { unsigned kv[8]; float dc[8];
#pragma unroll
            for (int i = 0; i < 8; ++i) { const size_t u = (size_t)bh * 128 + n0 + i; kv[i] = KVS[(u * 64 + d) * 64 + e2]; dc[i] = DEC[u * 64 + d]; }
#pragma unroll
            for (int i = 0; i < 8; ++i) { const size_t u = (size_t)bh * 128 + n0 + i; KVS[(u * 64 + d) * 64 + e2] = cvtpk(s0, s1); s0 = s0 * dc[i] + bflo(kv[i]); s1 = s1 * dc[i] + bfhi(kv[i]); } }
    }
}
__device__ __forceinline__ void gla_g3(Frame& F) {
    LAS unsigned char* L = F.lds;
    LAS unsigned char* QD = L; LAS unsigned char* KD = L + 9216; LAS unsigned char* VL = L + 18432; LAS unsigned char* ST = L + 35840; LAS unsigned char* GRs = L + 53248; LAS unsigned char* OUT = L + 70656;
    LAS float* SS = (LAS float*)(L + 88064);
    const bf16_t* GQ = (const bf16_t*)(F.ws + WS_GQ); const bf16_t* GK = (const bf16_t*)(F.ws + WS_GK); const bf16_t* GV = (const bf16_t*)(F.ws + WS_GV); const bf16_t* GR = (const bf16_t*)(F.ws + WS_GR);
    const bf16_t* KVS = (const bf16_t*)(F.ws + WS_KVS); bf16_t* Y = (bf16_t*)(F.ws + WS_XN); const float* og = F.in[I_GOG];
    const int tid = (F.wave * 64 + lane_id()), lane = lane_id(), w = F.wave, tb = w & 1, eb = w >> 1, hh = lane >> 5, l31 = lane & 31, blk = (lane >> 4) & 1, q4 = (lane & 15) >> 2, p4 = lane & 3;
    for (int u = F.vcu; u < 4096; u += F.G) {
        const int n = u & 127, bh = u >> 7, h = bh & 3, b = bh >> 2; const size_t row0 = (size_t)b * SEQ + 64 * n;
        { const int t = tid >> 3, c = tid & 7;
            *(LAS u32x4*)(QD + t * 144 + 16 * c) = *(const u32x4*)(GQ + (row0 + t) * 256 + h * 64 + 8 * c);
            *(LAS u32x4*)(KD + t * 144 + 16 * c) = *(const u32x4*)(GK + (row0 + t) * 256 + h * 64 + 8 * c); }
#pragma unroll
        for (int p = 0; p < 2; ++p) { const int idx = tid + 512 * p, t = idx >> 4, c = idx & 15;
            *(LAS u32x4*)(VL + t * 272 + 16 * c) = *(const u32x4*)(GV + (row0 + t) * 512 + h * 128 + 8 * c);
            *(LAS u32x4*)(ST + t * 272 + 16 * c) = *(const u32x4*)(KVS + ((size_t)u * 64 + t) * 128 + 8 * c);
            *(LAS u32x4*)(GRs + t * 272 + 16 * c) = *(const u32x4*)(GR + (row0 + t) * 512 + h * 128 + 8 * c); }
        __syncthreads();
        bf16x8 qf[4];
#pragma unroll
        for (int ks = 0; ks < 4; ++ks) qf[ks] = *(const LAS bf16x8*)(QD + (32 * tb + l31) * 144 + (16 * ks + 8 * hh) * 2);
        f32x16 o; for (int i = 0; i < 16; ++i) o[i] = 0.f;
#pragma unroll
        for (int sb = 0; sb < 2; ++sb) { f32x16 at; for (int i = 0; i < 16; ++i) at[i] = 0.f;
#pragma unroll
            for (int ks = 0; ks < 4; ++ks) at = MFMA32(*(const LAS bf16x8*)(KD + (32 * sb + l31) * 144 + (16 * ks + 8 * hh) * 2), qf[ks], at);
#pragma unroll
            for (int i = 0; i < 16; ++i) if (32 * sb + crow(i, hh) > 32 * tb + l31) at[i] = 0.f;
#pragma unroll
            for (int s2 = 0; s2 < 2; ++s2) { const int r0 = 32 * sb + 16 * s2 + 4 * hh + q4;
                const bf16x8 va = cat8(tr4(VL + r0 * 272 + (32 * eb + 16 * blk + 4 * p4) * 2), tr4(VL + (r0 + 8) * 272 + (32 * eb + 16 * blk + 4 * p4) * 2));
                o = MFMA32(va, pack_step(at, s2), o); } }
#pragma unroll
        for (int ks = 0; ks < 4; ++ks) { const int r0 = 16 * ks + 8 * hh + q4;
            const bf16x8 sa = cat8(tr4(ST + r0 * 272 + (32 * eb + 16 * blk + 4 * p4) * 2), tr4(ST + (r0 + 4) * 272 + (32 * eb + 16 * blk + 4 * p4) * 2));
            o = MFMA32(sa, qf[ks], o); }
        float ss = 0.f;
#pragma unroll
        for (int i = 0; i < 16; ++i) ss += o[i] * o[i];
        ss += swap32(ss);
        if (hh == 0) SS[eb * 64 + 32 * tb + l31] = ss;
        __syncthreads();
        { const int t = 32 * tb + l31; const float tot = (SS[t] + SS[64 + t]) + (SS[128 + t] + SS[192 + t]); const float rs = __builtin_amdgcn_rsqf(tot * (1.f / 128.f) + EPS);
#pragma unroll
            for (int g4 = 0; g4 < 4; ++g4) { const int e = 32 * eb + 8 * g4 + 4 * hh; const u32x2 rr = *(const LAS u32x2*)(GRs + t * 272 + e * 2); const f32x4 gg = *(const f32x4*)(og + e);
                u32x2 wv; wv.x = cvtpk(o[4 * g4] * rs * gg[0] * bflo(rr.x), o[4 * g4 + 1] * rs * gg[1] * bfhi(rr.x)); wv.y = cvtpk(o[4 * g4 + 2] * rs * gg[2] * bflo(rr.y), o[4 * g4 + 3] * rs * gg[3] * bfhi(rr.y));
                *(LAS u32x2*)(OUT + t * 272 + e * 2) = wv; } }
        __syncthreads();
#pragma unroll
        for (int p = 0; p < 2; ++p) { const int idx = tid + 512 * p, t = idx >> 4, c = idx & 15;
            *(u32x4*)(Y + (row0 + t) * DM + h * 128 + 8 * c) = *(const LAS u32x4*)(OUT + t * 272 + 16 * c); }
        __syncthreads();
    }
}
constexpr int AT_KB = 16384, AT_VB = 16384;
constexpr int AT_K0 = 0, AT_V0 = 2 * AT_KB, AT_XCH = 0, AT_BIAS = 2 * AT_KB + 3 * AT_VB, AT_LAM = AT_BIAS + 512, AT_OSTR = 272;
constexpr float AT_THR = 8.f;
__device__ __forceinline__ float max3f(float a, float b, float c) { float r; asm("v_max3_f32 %0, %1, %2, %3" : "=v"(r) : "v"(a), "v"(b), "v"(c)); return r; }
__device__ __forceinline__ float xmax32(float v) { auto rr = __builtin_amdgcn_permlane32_swap(__float_as_uint(v), __float_as_uint(v), false, false); return max3f(__uint_as_float(rr[0]), __uint_as_float(rr[1]), v); }
__device__ __forceinline__ float xsum32(float v) { auto rr = __builtin_amdgcn_permlane32_swap(__float_as_uint(v), __float_as_uint(v), false, false); return __uint_as_float(rr[0]) + __uint_as_float(rr[1]); }
__device__ __forceinline__ void at_dma(const void* gbase, unsigned voff, unsigned lds_dst) { unsigned keep;
    asm volatile("s_mov_b32 %0, m0\n\ts_mov_b32 m0, %3\n\ts_nop 0\n\tglobal_load_lds_dwordx4 %1, %2\n\ts_mov_b32 m0, %0" : "=&s"(keep) : "v"(voff), "s"(gbase), "s"(lds_dst) : "memory"); }
__device__ __forceinline__ const bf16_t* uni_ptr(const bf16_t* p) { const unsigned long long v = (unsigned long long)p; const unsigned lo = __builtin_amdgcn_readfirstlane((unsigned)v), hi = __builtin_amdgcn_readfirstlane((unsigned)(v >> 32)); return (const bf16_t*)(((unsigned long long)hi << 32) | lo); }
#define AT_WAITBAR() asm volatile("s_waitcnt vmcnt(0) lgkmcnt(0)\n\ts_barrier" ::: "memory")
#define AT_VFR(dst, Vb, kst) do { _Pragma("unroll") for (int eb = 0; eb < 4; ++eb) dst[eb] = cat8(tr4((Vb) + vb0 + (kst) * 4096 + eb * 512), tr4((Vb) + vb1 + (kst) * 4096 + eb * 512)); } while (0)
#define AT_PV(Vb, PF) do { _Pragma("unroll") for (int kst = 0; kst < 4; ++kst) { bf16x8 vf_[4]; AT_VFR(vf_, Vb, kst); \
        _Pragma("unroll") for (int eb = 0; eb < 4; ++eb) o[eb] = MFMA32(vf_[eb], PF[kst], o[eb]); } } while (0)
#define AT_QK(S0, S1, Kb) do { S0 = MFMA32(*(const LAS bf16x8*)((Kb) + kofs[0]), qf[0], negm); S1 = MFMA32(*(const LAS bf16x8*)((Kb) + kofs[0] + 4096), qf[0], negm); \
        _Pragma("unroll") for (int ks = 1; ks < 4; ++ks) { S0 = MFMA32(*(const LAS bf16x8*)((Kb) + kofs[ks]), qf[ks], S0); S1 = MFMA32(*(const LAS bf16x8*)((Kb) + kofs[ks] + 4096), qf[ks], S1); } } while (0)
#define AT_STEP(i, S0, S1, PF, KNB) do { \
    if ((i) + 2 < NT) { const bf16_t* gk_ = uni_ptr(DKu + (size_t)((i) + 2) * 64 * 512); at_dma(gk_, kvo[0], lds0 + AT_K0 + (((i) & 1) * AT_KB) + w * 1024); at_dma(gk_, kvo[1], lds0 + AT_K0 + (((i) & 1) * AT_KB) + 8192 + w * 1024); } \
    if ((i) + 1 < NT) { const bf16_t* gv_ = uni_ptr(DVu + (size_t)((i) + 1) * 64 * 512); at_dma(gv_, vvo[0], lds0 + AT_V0 + vnext + w * 1024); at_dma(gv_, vvo[1], lds0 + AT_V0 + vnext + 8192 + w * 1024); } \
    if ((i) < NA) { \
        if (64 * (i) + 176 > qw0) { const int d0_ = qpos - 64 * (i);                  \
            _Pragma("unroll") for (int r_ = 0; r_ < 16; ++r_) { const int dd_ = d0_ - crow(r_, hh); S0[r_] = dd_ < 0 ? -1e30f : S0[r_] + BT[dd_ > 127 ? 127 : dd_]; \
                const int d2_ = dd_ - 32; S1[r_] = d2_ < 0 ? -1e30f : S1[r_] + BT[d2_ > 127 ? 127 : d2_]; } } \
        float mx_ = max3f(S0[0], S1[0], S0[1]); mx_ = max3f(mx_, S1[1], S0[2]); \
        _Pragma("unroll") for (int r_ = 3; r_ < 15; r_ += 2) { mx_ = max3f(mx_, S0[r_], S1[r_ - 1]); mx_ = max3f(mx_, S0[r_ + 1], S1[r_]); } \
        mx_ = max3f(mx_, S0[15], S1[14]); mx_ = xmax32(fmaxf(mx_, S1[15])); \
        if (__any(mx_ > AT_THR)) {                                                   \
            { const LAS unsigned char* Vp_ = L + AT_V0 + vprev; AT_PV(Vp_, PF); } \
            _Pragma("unroll") for (int k_ = 0; k_ < 4; ++k_) PF[k_] = (bf16x8){0, 0, 0, 0, 0, 0, 0, 0}; \
            const float dl_ = fmaxf(mx_, 0.f), al_ = fast_exp2(-dl_); lrun *= al_; mref += dl_; \
            _Pragma("unroll") for (int r_ = 0; r_ < 16; ++r_) { negm[r_] = -mref; S0[r_] -= dl_; S1[r_] -= dl_; } \
            _Pragma("unroll") for (int eb = 0; eb < 4; ++eb) _Pragma("unroll") for (int r_ = 0; r_ < 16; ++r_) o[eb][r_] *= al_; } \
        { const LAS unsigned char* Vp_ = L + AT_V0 + vprev; AT_PV(Vp_, PF); } \
        float pa_ = 0.f, pb_ = 0.f; \
        _Pragma("unroll") for (int r_ = 0; r_ < 16; ++r_) { S0[r_] = fast_exp2(S0[r_]); S1[r_] = fast_exp2(S1[r_]); pa_ += S0[r_]; pb_ += S1[r_]; } \
        lrun += pa_ + pb_; \
        PF[0] = pack_step(S0, 0); PF[1] = pack_step(S0, 1); PF[2] = pack_step(S1, 0); PF[3] = pack_step(S1, 1); \
        { const LAS unsigned char* Kb_ = L + AT_K0 + (KNB); AT_QK(S0, S1, Kb_); } \
    } else if ((i) == NA) { const LAS unsigned char* Vp_ = L + AT_V0 + vprev; AT_PV(Vp_, PF); } \
    vprev = vcur; vcur = vnext; vnext = (vnext == 2 * AT_VB) ? 0 : vnext + AT_VB; \
    AT_WAITBAR(); } while (0)

__device__ __forceinline__ void attn_phase(Frame& F) {
    LAS unsigned char* L = F.lds; const unsigned lds0 = (unsigned)(uintptr_t)F.lds;
    const bf16_t* DQ = (const bf16_t*)(F.ws + WS_DQ); const bf16_t* DK = (const bf16_t*)(F.ws + WS_DK); const bf16_t* DV = (const bf16_t*)(F.ws + WS_DV); bf16_t* Y = (bf16_t*)(F.ws + WS_XN);
    const int w = F.wave, c = w >> 2, jw = w & 3;
    LAS float* BT = (LAS float*)(L + AT_BIAS); LAS float* LAMP = (LAS float*)(L + AT_LAM);
    if (w == 0) { const int l0 = lane_id(); const float a = F.in[I_LQ1][l0] * F.in[I_LK1][l0], b = F.in[I_LQ2][l0] * F.in[I_LK2][l0];
        const float sa = wave_sum(a), sb = wave_sum(b); if (l0 == 0) LAMP[0] = __expf(sa) - __expf(sb) + 0.2f; }
    const float* subg = F.in[I_SUBG]; const float* relb = F.in[I_RELB];
    for (int vv = F.vcu; vv < 256; vv += F.G) {
        const int bh = vv >> 3, sidx = vv & 7, h = bh & 3, b = bh >> 2; const size_t rowbase = (size_t)b * SEQ;
        __syncthreads();
        { const int n = w * 64 + lane_id(); if (n < 128) { int bucket = n;
            if (n >= 16) { bucket = 16 + (int)(__logf((float)n * (1.f / 16.f)) / __logf(8.f) * 16.f); if (bucket > 31) bucket = 31; }
            BT[n] = (relb[bucket * 4 + h] - relb[31 * 4 + h]) * LOG2E; } }
        for (int ui = 0; ui < 8; ++ui) {
            const int pr = ui >> 1, qb = (ui & 1) ? (63 - 8 * pr - sidx) : (8 * pr + sidx);
            const int lane = lane_id(), hh = lane >> 5, ql = lane & 31, blk = (lane >> 4) & 1, q4 = (lane & 15) >> 2, p4 = lane & 3;
            const int vb0 = 64 * (4 * hh + q4) + 16 * ((2 * blk + (p4 >> 1)) ^ hh) + 8 * (p4 & 1), vb1 = 2048 + 64 * (4 * hh + q4) + 16 * ((2 * blk + (p4 >> 1)) ^ ((2 + hh) & 3)) + 8 * (p4 & 1);
            int kofs[4];
#pragma unroll
            for (int ks = 0; ks < 4; ++ks) kofs[ks] = c * 8192 + ql * 128 + 16 * ((2 * ks + hh) ^ ((ql >> 1) & 7));
            unsigned kvo[2], vvo[2];
#pragma unroll
            for (int p = 0; p < 2; ++p) { const int r = 8 * w + (lane >> 3), ch = (lane & 7) ^ ((r >> 1) & 7); kvo[p] = (unsigned)(r * 1024 + (h * 128 + p * 64 + 8 * ch) * 2);
                const int j = w + 8 * p, row = 8 * (j >> 1) + ((lane >> 2) & 7), chv = 4 * (2 * (j & 1) + (lane >> 5)) + ((lane & 3) ^ ((row >> 2) & 3)); vvo[p] = (unsigned)(row * 1024 + (h * 128 + 8 * chv) * 2); }
            const int q0 = qb * 128, NT = (q0 + 128) >> 6, qw0 = q0 + 32 * jw, qpos = qw0 + ql;
            const int NA = min(NT, ((qw0 + 31) >> 6) + 1);
            const bf16_t* DKu = DK + rowbase * 512; const bf16_t* DVu = DV + rowbase * 512;
            bf16x8 qf[4];
#pragma unroll
            for (int ks = 0; ks < 4; ++ks) qf[ks] = *(const bf16x8*)(DQ + (rowbase + qpos) * 512 + h * 128 + c * 64 + 16 * ks + 8 * hh);
            __syncthreads();
            { const bf16_t* g0 = uni_ptr(DKu); const bf16_t* g1 = uni_ptr(DKu + 64 * 512); const bf16_t* gv = uni_ptr(DVu);
                at_dma(g0, kvo[0], lds0 + AT_K0 + w * 1024); at_dma(g0, kvo[1], lds0 + AT_K0 + 8192 + w * 1024);
                at_dma(g1, kvo[0], lds0 + AT_K0 + AT_KB + w * 1024); at_dma(g1, kvo[1], lds0 + AT_K0 + AT_KB + 8192 + w * 1024);
                at_dma(gv, vvo[0], lds0 + AT_V0 + w * 1024); at_dma(gv, vvo[1], lds0 + AT_V0 + 8192 + w * 1024); }
            f32x16 o[4];
#pragma unroll
            for (int eb = 0; eb < 4; ++eb) for (int i = 0; i < 16; ++i) o[eb][i] = 0.f;
            float mref = 0.f, lrun = 0.f;
            f32x16 negm;
#pragma unroll
            for (int i = 0; i < 16; ++i) negm[i] = 0.f;
            bf16x8 pf[4];
#pragma unroll
            for (int k = 0; k < 4; ++k) pf[k] = (bf16x8){0, 0, 0, 0, 0, 0, 0, 0};
            int vprev = 0, vcur = 0, vnext = AT_VB;
            AT_WAITBAR();
            f32x16 s0, s1;
            { const LAS unsigned char* Kb = L + AT_K0; AT_QK(s0, s1, Kb); }
            for (int i = 0; i < NT; i += 2) {
                AT_STEP(i, s0, s1, pf, AT_KB);
                AT_STEP(i + 1, s0, s1, pf, 0);
            }
            if (NA == NT) { const LAS unsigned char* Vp = L + AT_V0 + vprev; AT_PV(Vp, pf); }
            AT_WAITBAR();
            const float ltot = xsum32(lrun); const float inv = fast_rcp(ltot);
            const int lane2 = lane_id();
            const int ql2 = lane2 & 31, hh2 = lane2 >> 5;
            LAS float* X = (LAS float*)(L + AT_XCH) + jw * 4096;
            if (c == 1) { const float sc = inv * LAMP[0];
#pragma unroll
                for (int eb = 0; eb < 4; ++eb) for (int i = 0; i < 16; ++i) X[(eb * 16 + i) * 64 + lane2] = o[eb][i] * sc; }
            __syncthreads();
            if (c == 0) { float ss = 0.f;
#pragma unroll
                for (int eb = 0; eb < 4; ++eb) for (int i = 0; i < 16; ++i) { const float v = o[eb][i] * inv - X[(eb * 16 + i) * 64 + lane2]; o[eb][i] = v; ss += v * v; }
                ss = xsum32(ss);
                const float rs = __builtin_amdgcn_rsqf(ss * (1.f / 128.f) + EPS) * 0.8f;
                LDS_WAIT();
                LAS unsigned char* OS = (LAS unsigned char*)X;
#pragma unroll
                for (int eb = 0; eb < 4; ++eb)
#pragma unroll
                    for (int g4 = 0; g4 < 4; ++g4) { const int e = 32 * eb + 8 * g4 + 4 * hh2; const f32x4 gg = *(const f32x4*)(subg + e);
                        u32x2 wv; wv.x = cvtpk(o[eb][4 * g4] * rs * gg[0], o[eb][4 * g4 + 1] * rs * gg[1]); wv.y = cvtpk(o[eb][4 * g4 + 2] * rs * gg[2], o[eb][4 * g4 + 3] * rs * gg[3]);
                        *(LAS u32x2*)(OS + ql2 * AT_OSTR + e * 2) = wv; }
                LDS_WAIT();
#pragma unroll
                for (int p = 0; p < 8; ++p) { const int idx = lane2 + 64 * p, r = idx >> 4, ch = idx & 15;
                    *(u32x4*)(Y + (rowbase + qw0 + r) * DM + 512 + h * 128 + 8 * ch) = *(const LAS u32x4*)(OS + r * AT_OSTR + 16 * ch); }
            }
        }
    }
}
#undef AT_PV
#undef AT_VFR
#undef AT_QK
#undef AT_STEP
#undef AT_WAITBAR
constexpr int RT_TSTR = 272;
constexpr int RT_TILE = 0, RT_LOG = 8 * 32 * RT_TSTR, RT_RS = RT_LOG + 8 * 32 * 33 * 4, RT_CNT = RT_RS + 8 * 32 * 4, RT_BASE = RT_CNT + 128;
__device__ __forceinline__ void route_phase(Frame& F) {
    LAS unsigned char* L = F.lds;
    const float* H = F.out; unsigned char* M2 = F.ws + WS_XN; const float* gn = F.in[I_N2G]; const float* br = F.in[I_BR];
    const bf16_t* wrf = (const bf16_t*)(F.ws + WS_WRF); int* ldst = (int*)(F.ws + WS_LDST); float* lgate = (float*)(F.ws + WS_LGATE);
    const int tid = (F.wave * 64 + lane_id()), lane = lane_id(), w = F.wave, hh = lane >> 5, l31 = lane & 31;
    LAS unsigned char* TL = L + RT_TILE + w * 32 * RT_TSTR; LAS float* LG = (LAS float*)(L + RT_LOG) + w * 32 * 33; LAS float* RS = (LAS float*)(L + RT_RS) + w * 32;
    LAS int* CNT = (LAS int*)(L + RT_CNT); LAS int* BASE = (LAS int*)(L + RT_BASE);
    for (int bt = F.vcu; bt < T / 256; bt += F.G) {
        const size_t row0 = (size_t)bt * 256 + 32 * w;
        if (tid < 32) CNT[tid] = 0;
        for (int r = 0; r < 32; ++r) { const f32x4* xr = (const f32x4*)(H + (row0 + r) * DM) + lane; float s = 0.f;
#pragma unroll
            for (int j = 0; j < 4; ++j) { const f32x4 v = xr[64 * j]; s += (v.x * v.x + v.y * v.y) + (v.z * v.z + v.w * v.w); }
            s = wave_sum(s); if (lane == 0) RS[r] = __builtin_amdgcn_rsqf(s * (1.f / DM) + EPS); }
        LDS_WAIT();
        f32x16 acc; for (int i = 0; i < 16; ++i) acc[i] = 0.f;
        for (int ch = 0; ch < 8; ++ch) { const int col = 128 * ch + 4 * l31; const f32x4 g = *(const f32x4*)(gn + col);
#pragma unroll 4
            for (int i = 0; i < 16; ++i) { const int r = 2 * i + hh; const f32x4 v = *(const f32x4*)(H + (row0 + r) * DM + col) * (RS[r] * g);
                u32x2 wv; wv.x = cvtpk(v.x, v.y); wv.y = cvtpk(v.z, v.w);
                *(unsigned*)(M2 + (row0 + r) * DM + col) = pk4_fp8(v.x, v.y, v.z, v.w); *(LAS u32x2*)(TL + r * RT_TSTR + 8 * l31) = wv; }
            LDS_WAIT();
#pragma unroll
            for (int ks = 0; ks < 8; ++ks) { const bf16x8 a = *(const LAS bf16x8*)(TL + l31 * RT_TSTR + (16 * ks + 8 * hh) * 2); const bf16x8 bfr = *(const bf16x8*)(wrf + ((size_t)(8 * ch + ks) * 64 + lane) * 8);
                acc = MFMA32(a, bfr, acc); }
            LDS_WAIT();
        }
#pragma unroll
        for (int i = 0; i < 16; ++i) LG[crow(i, hh) * 33 + l31] = acc[i];
        LDS_WAIT();
        __syncthreads();
        int ek[4] = {0, 0, 0, 0}; float gk[4] = {0.f, 0.f, 0.f, 0.f}; int pk[4] = {0, 0, 0, 0};
        if (lane < 32) { float v[32];
#pragma unroll
            for (int e = 0; e < 32; ++e) v[e] = LG[lane * 33 + e] + br[e];
            unsigned taken = 0u; float tv[4];
#pragma unroll
            for (int k = 0; k < 4; ++k) { float best = -3.0e38f; int bi = 0;
#pragma unroll
                for (int e = 0; e < 32; ++e) { const bool ok = !((taken >> e) & 1u) && v[e] > best; best = ok ? v[e] : best; bi = ok ? e : bi; }
                taken |= 1u << bi; ek[k] = bi; tv[k] = best; }
            const float e1 = __expf(tv[1] - tv[0]), e2 = __expf(tv[2] - tv[0]), e3 = __expf(tv[3] - tv[0]); const float inv = 1.f / (1.f + e1 + e2 + e3);
            gk[0] = inv; gk[1] = e1 * inv; gk[2] = e2 * inv; gk[3] = e3 * inv;
#pragma unroll
            for (int k = 0; k < 4; ++k) pk[k] = __hip_atomic_fetch_add(CNT + ek[k], 1, __ATOMIC_RELAXED, __HIP_MEMORY_SCOPE_WORKGROUP); }
        __syncthreads();
        if (tid < 32) BASE[tid] = (int)__hip_atomic_fetch_add(F.ctl + CW_CNT + 64 * tid, (unsigned)CNT[tid], RLX_AGENT);
        __syncthreads();
        if (lane < 32) { const int tok = (int)row0 + lane;
#pragma unroll
            for (int k = 0; k < 4; ++k) { const int p = BASE[ek[k]] + pk[k]; ldst[ek[k] * 65536 + p] = tok * 4 + k; lgate[ek[k] * 65536 + p] = gk[k]; } }
        __syncthreads();
    }
}

__device__ __forceinline__ void combine_phase(Frame& F) {
    const int gw = F.vcu * 8 + F.wave, NGW = F.G * 8;
    const bf16_t* Y0 = (const bf16_t*)(F.ws + WS_YS0); const bf16_t* Y1 = (const bf16_t*)(F.ws + WS_YS1); const bf16_t* Y2 = (const bf16_t*)(F.ws + WS_YS2);
    for (int m = gw; m < T; m += NGW) { f32x4* op = (f32x4*)(F.out + (size_t)m * DM) + lane_id();
        const u32x2* a = (const u32x2*)(Y0 + (size_t)m * DM) + lane_id(); const u32x2* b = (const u32x2*)(Y1 + (size_t)m * DM) + lane_id(); const u32x2* c = (const u32x2*)(Y2 + (size_t)m * DM) + lane_id();
#pragma unroll
        for (int j = 0; j < 4; ++j) { f32x4 o = op[64 * j]; const u32x2 x = a[64 * j], y = b[64 * j], z = c[64 * j];
            o.x += (bflo(x.x) + bflo(y.x)) + bflo(z.x); o.y += (bfhi(x.x) + bfhi(y.x)) + bfhi(z.x); o.z += (bflo(x.y) + bflo(y.y)) + bflo(z.y); o.w += (bfhi(x.y) + bfhi(y.y)) + bfhi(z.y);
            op[64 * j] = o; } }
}

#ifndef PROBE_DUP
#define PROBE_DUP -1
#endif
struct Args { const float* in[22]; float* out; unsigned char* ws; int ph_lo, ph_hi; };
constexpr int NPHASE = 10;
__global__ void __launch_bounds__(512, 2) hymba_fwd(Args args) {
    extern __shared__ __attribute__((aligned(16))) unsigned char lds[];
    Frame F;
    F.lds = (LAS unsigned char*)lds;
    F.wave = __builtin_amdgcn_readfirstlane((int)threadIdx.x >> 6);
    F.G = gridDim.x; { const int bx = blockIdx.x; F.vcu = (F.G % 8 == 0) ? (bx % 8) * (F.G / 8) + bx / 8 : bx; }
    F.ws = args.ws; F.out = args.out; F.ctl = (gu32*)(args.ws + WS_CTL);
#pragma unroll
    for (int i = 0; i < 22; ++i) F.in[i] = args.in[i];
    if ((F.wave * 64 + lane_id()) < 64) ((LAS unsigned*)(F.lds + LDS_CTL_OFF))[(F.wave * 64 + lane_id())] = 0u;
    __syncthreads();
    const int lo = args.ph_lo, hi = args.ph_hi;
    const bool multi = (hi - lo) > 1;
    XcdBarrier bar; bar.bar = (unsigned*)(F.ctl + CW_BAR); bar.x = 0; bar.st = nullptr; bar.wave = F.wave;
    if (multi) bar = xcd_barrier_post((unsigned*)(F.ctl + CW_BAR), (volatile LAS unsigned*)(F.lds + LDS_CTL_OFF), F.wave);
#define IN(k) (lo <= (k) && (k) < hi)
#define SEAM(k) do { if (IN(k) && IN((k) + 1)) xcd_barrier(bar); } while (0)
    if (IN(0)) { p0_prologue(F); if (PROBE_DUP == 0) { __syncthreads(); p0_prologue(F); } } SEAM(0);
    if (IN(1)) { pg8::DenseOrder S; S.init(F.ws + WS_XN, F.ws + WS_WIN, T, NIN, DM, F.G, (int)blockIdx.x);
        EpiInProj E{F.ws, F.in[I_BG2], F.in[I_QG], F.in[I_KG]};
        pg8::gemm_phase<EpiInProj, pg8::DenseOrder>(F.lds, DM * 2, F.wave, S, E); if (PROBE_DUP == 1) { __syncthreads(); pg8::gemm_phase<EpiInProj, pg8::DenseOrder>(F.lds, DM * 2, F.wave, S, E); } } SEAM(1);
    if (IN(2)) { gla_g01(F); } SEAM(2);
    if (IN(3)) { gla_scan(F); } SEAM(3);
    if (IN(4)) { attn_phase(F); __syncthreads(); if (PROBE_DUP == 4) { attn_phase(F); __syncthreads(); } gla_g3(F); if (PROBE_DUP == 41) { __syncthreads(); gla_g3(F); } } SEAM(4);
    if (IN(5)) { pg8::DenseOrder S; S.init(F.ws + WS_XN, F.ws + WS_WOUT, T, DM, DM, F.G, (int)blockIdx.x);
        EpiResid E{F.in[I_X], F.out};
        pg8::gemm_phase<EpiResid, pg8::DenseOrder>(F.lds, DM * 2, F.wave, S, E); if (PROBE_DUP == 5) { __syncthreads(); pg8::gemm_phase<EpiResid, pg8::DenseOrder>(F.lds, DM * 2, F.wave, S, E); } } SEAM(5);
    if (IN(6)) { route_phase(F); } SEAM(6);
    if (IN(7) || IN(8)) {
        LAS int* tab = (LAS int*)(F.lds + LDS_TAB_OFF);
        __syncthreads();
        if ((F.wave * 64 + lane_id()) == 0) { int ts = 0, rp = 0;
            for (int e = 0; e < 32; ++e) { const int c = (int)__hip_atomic_load(F.ctl + CW_CNT + 64 * e, RLX_AGENT); tab[e] = ts; tab[40 + e] = rp; tab[80 + e] = c; ts += (c + 255) >> 8; rp += c; }
            tab[32] = ts; tab[72] = rp; }
        __syncthreads();
    }
    if (IN(7)) { MoeOrder S{(const LAS int*)(F.lds + LDS_TAB_OFF), F.G, F.vcu, 8, 1, (const char*)(F.ws + WS_XN), (const char*)(F.ws + WS_WGU), (const int*)(F.ws + WS_LDST)};
        EpiGateUp E{F.ws + WS_HID, F.in[I_BGU]};
        pg8::gemm_phase<EpiGateUp, MoeOrder, true>(F.lds, DM, F.wave, S, E); if (PROBE_DUP == 7) { __syncthreads(); pg8::gemm_phase<EpiGateUp, MoeOrder, true>(F.lds, DM, F.wave, S, E); } } SEAM(7);
    if (IN(8)) { MoeOrder S{(const LAS int*)(F.lds + LDS_TAB_OFF), F.G, F.vcu, 4, 0, (const char*)(F.ws + WS_HID), (const char*)(F.ws + WS_WD), (const int*)(F.ws + WS_LDST)};
        EpiDown E{F.ws, F.out, F.in[I_BD]};
        pg8::gemm_phase<EpiDown, MoeOrder, true>(F.lds, DM, F.wave, S, E); } SEAM(8);
    if (IN(9)) { combine_phase(F); }
#undef IN
#undef SEAM
}

#ifndef MK_N_LAUNCHES
#define MK_N_LAUNCHES 1
#endif
extern "C" void kernel_launch(void* const* d_in, const int* in_sizes, int n_in, void* d_out, int out_size, void* d_ws, size_t ws_size, hipStream_t stream) {
    static int grid = 0;
    if (grid == 0) {
        if (n_in != 22 || in_sizes[0] != T * DM || out_size != T * DM || ws_size < WS_END) { fprintf(stderr, "kernel_launch: unexpected shapes / workspace (n_in %d, ws %zu)\n", n_in, ws_size); grid = -1; return; }
        int dev = 0, cus = 0, per_cu = 0;
        if (hipGetDevice(&dev) != hipSuccess || hipDeviceGetAttribute(&cus, hipDeviceAttributeMultiprocessorCount, dev) != hipSuccess) { grid = -1; return; }
        if (hipFuncSetAttribute((const void*)hymba_fwd, hipFuncAttributeMaxDynamicSharedMemorySize, LDS_BYTES) != hipSuccess) { fprintf(stderr, "kernel_launch: hipFuncSetAttribute failed\n"); grid = -1; return; }
        if (hipOccupancyMaxActiveBlocksPerMultiprocessor(&per_cu, (const void*)hymba_fwd, 512, LDS_BYTES) != hipSuccess || per_cu < 1) fprintf(stderr, "kernel_launch: occupancy query says %d\n", per_cu);
        (void)hipGetLastError();
        grid = cus;
    }
    if (grid < 0) return;
    if (hipMemsetAsync((char*)d_ws + WS_CTL, 0, CTL_ZERO_BYTES, stream) != hipSuccess) return;
    Args a{};
    for (int i = 0; i < 22; ++i) a.in[i] = (const float*)d_in[i];
    a.out = (float*)d_out; a.ws = (unsigned char*)d_ws;
    if (MK_N_LAUNCHES == 1) { a.ph_lo = 0; a.ph_hi = NPHASE; hipLaunchKernelGGL(hymba_fwd, dim3(grid), dim3(512), LDS_BYTES, stream, a); }
    else for (int p = 0; p < NPHASE; ++p) { a.ph_lo = p; a.ph_hi = p + 1; hipLaunchKernelGGL(hymba_fwd, dim3(grid), dim3(512), LDS_BYTES, stream, a); }
}
```

```cpp
#include <hip/hip_runtime.h>
#include <cstdio>
#include <cstdint>

#define LAS __attribute__((address_space(3)))
#define GAS __attribute__((address_space(1)))
typedef unsigned short bf16_t;
typedef short bf16x8 __attribute__((ext_vector_type(8)));
typedef short s16x4 __attribute__((ext_vector_type(4)));
typedef float f32x2 __attribute__((ext_vector_type(2)));
typedef float f32x4 __attribute__((ext_vector_type(4)));
typedef float f32x16 __attribute__((ext_vector_type(16)));
typedef unsigned u32x2 __attribute__((ext_vector_type(2)));
typedef unsigned u32x4 __attribute__((ext_vector_type(4)));
typedef __bf16 bf16x2_t __attribute__((ext_vector_type(2)));
typedef GAS unsigned gu32;

constexpr int NB = 8, SEQ = 8192, DM = 1024, T = NB * SEQ;
constexpr int NIN = 3328;
constexpr int NE = 32, TOPK = 4, DFF = 1024;
constexpr int GLA_C = 64, NCH = SEQ / GLA_C;
constexpr float EPS = 1e-6f;
constexpr float LOG2E = 1.4426950408889634f;

constexpr size_t MiB = 1u << 20;
constexpr size_t WS_CTL = 0, CTL_ZERO_BYTES = 1 * MiB;
constexpr size_t WS_DECAY = 1 * MiB;
constexpr size_t WS_WRF = 2 * MiB;
constexpr size_t WS_WIN = 4 * MiB;
constexpr size_t WS_WOUT = 11 * MiB;
constexpr size_t WS_LDST = 13 * MiB;
constexpr size_t WS_LGATE = 21 * MiB;
constexpr size_t WS_WD = 32 * MiB;
constexpr size_t WS_WGU = 96 * MiB;
constexpr size_t WS_XN = 224 * MiB;
constexpr size_t WS_R = 352 * MiB;
constexpr size_t WS_GQ = WS_R, WS_GK = WS_R + 32 * MiB, WS_GV = WS_R + 64 * MiB, WS_GA = WS_R + 128 * MiB, WS_GR = WS_R + 192 * MiB;
constexpr size_t WS_DQ = WS_R + 256 * MiB, WS_DK = WS_R + 320 * MiB, WS_DV = WS_R + 384 * MiB, WS_KVS = WS_R + 448 * MiB;
constexpr size_t WS_HID = WS_R;
constexpr size_t WS_YS0 = WS_WGU, WS_YS1 = WS_XN, WS_YS2 = 864 * MiB, WS_YS3 = 608 * MiB;
constexpr size_t WS_LRS = 993 * MiB;
constexpr size_t WS_END = 1001 * MiB;
constexpr int CW_TMO = 0, CW_BAR = 4096, CW_CNT = 16384;

constexpr int LDS_BYTES = 147456;
constexpr int LDS_CTL_OFF = 146432;
constexpr int LDS_TAB_OFF = 131072;

#define LDS_WAIT() asm volatile("s_waitcnt lgkmcnt(0)" ::: "memory")
#define VM_WAIT() asm volatile("s_waitcnt vmcnt(0)" ::: "memory")
#define RLX_AGENT __ATOMIC_RELAXED, __HIP_MEMORY_SCOPE_AGENT

__device__ __forceinline__ unsigned cvtpk(float lo, float hi) { f32x2 v = {lo, hi}; bf16x2_t b = __builtin_convertvector(v, bf16x2_t); return __builtin_bit_cast(unsigned, b); }
__device__ __forceinline__ float bf2f(unsigned short b) { return __uint_as_float((unsigned)b << 16); }
__device__ __forceinline__ float bflo(unsigned w) { return __uint_as_float(w << 16); }
__device__ __forceinline__ float bfhi(unsigned w) { return __uint_as_float(w & 0xffff0000u); }
__device__ __forceinline__ float wave_sum(float v) {
#pragma unroll
    for (int o = 1; o < 64; o <<= 1) v += __shfl_xor(v, o);
    return v;
}
__device__ __forceinline__ int lane_id() { int l; asm volatile("v_mbcnt_lo_u32_b32 %0, -1, 0\n\tv_mbcnt_hi_u32_b32 %0, -1, %0" : "=v"(l)); return l; }
__device__ __forceinline__ float fast_exp2(float x) { return __builtin_amdgcn_exp2f(x); }
__device__ __forceinline__ float fast_rcp(float x) { return __builtin_amdgcn_rcpf(x); }
__device__ __forceinline__ float fast_sigmoid(float x) { return fast_rcp(1.0f + fast_exp2(-x * LOG2E)); }

namespace pg8 {
constexpr int BM = 256, BK = 64, HALF = 128, HTB = HALF * BK * 2, STAGE_BYTES = 8 * HTB, NXCD = 8, WGM = 4;
__host__ __device__ __forceinline__ int lds_byte(int r, int c) { const int st = (r >> 4) * 2 + (c >> 5), rr = r & 15, cc = c & 31, ob = rr * 64 + cc * 2; return st * 1024 + (ob ^ (((ob >> 9) & 1) << 5)); }
__host__ __device__ __forceinline__ void stage_rc(int b, int& R, int& C) { const int st = b / 1024, sb = b % 1024, swz = sb ^ (((sb >> 9) & 1) << 5); R = (st >> 1) * 16 + swz / 64; C = (st & 1) * 32 + (swz % 64) / 2; }
__host__ __device__ __forceinline__ int perm32(int rho) { const int n = rho >> 4, i = rho & 15; return 8 * (i >> 2) + 4 * n + (i & 3); }

struct Unit { int pm, pn, rows, row0, lst, e, par; };

struct DenseOrder {
    int nM, nN, nwg, G, c; const char* A; const char* Bt; int RB;
    __device__ __forceinline__ void init(const void* A_, const void* Bt_, int M, int N, int K_, int G_, int c_) { A = (const char*)A_; Bt = (const char*)Bt_; RB = K_ * 2; nM = M / BM; nN = N / BM; nwg = nM * nN; G = G_; c = c_; }
    __device__ __forceinline__ bool next(int i, Unit& u) const {
        const long L = (long)i * G + c; if (L >= nwg) return false;
        int wgid = (int)L; { const int q = nwg / NXCD, r = nwg % NXCD, xcd = wgid % NXCD, off = wgid / NXCD; wgid = (xcd < r ? xcd * (q + 1) : r * (q + 1) + (xcd - r) * q) + off; }
        const int nig = WGM * nN, gid = wgid / nig, fm = gid * WGM, gsz = (nM - fm) < WGM ? (nM - fm) : WGM;
        u.pm = fm + ((wgid % nig) % gsz); u.pn = (wgid % nig) / gsz; u.rows = 256; u.row0 = 0; u.lst = 0; u.e = 0; u.par = 0; return true;
    }
    __device__ __forceinline__ const char* a_base(const Unit& u) const { return A + (size_t)u.pm * (size_t)BM * RB; }
    __device__ __forceinline__ const char* b_base(const Unit& u) const { return Bt + (size_t)u.pn * (size_t)BM * RB; }
    __device__ __forceinline__ void prefetch(const Unit&, int, int, int) const {}
    __device__ __forceinline__ void prefetch_cur(const Unit&, int, int) const {}
    __device__ __forceinline__ void a_off_late(const Unit& u, int, const int (&R)[2], const int (&C)[2], unsigned (&o)[2][2]) const { a_off(u, R, C, o); }
    __device__ __forceinline__ void a_off(const Unit&, const int (&R)[2], const int (&C)[2], unsigned (&o)[2][2]) const {
#pragma unroll
        for (int h = 0; h < 2; ++h)
#pragma unroll
            for (int i = 0; i < 2; ++i) o[h][i] = (unsigned)((h * HALF + R[i]) * RB + C[i] * 2);
    }
};

typedef int v8i32 __attribute__((ext_vector_type(8)));
template <class Epi, class Sched, bool FP8 = false>
__device__ __forceinline__ void gemm_phase(LAS unsigned char* lds, const int RB, const int wid, const Sched& S, const Epi& E) {
    const int lane = lane_id(), tid = wid * 64 + lane, wr = wid >> 2, wc = wid & 3, fr = lane & 15, fq = lane >> 4;
    const int nt = RB / 128;
    int Rr[2], Cc[2]; unsigned voffB[2];
#pragma unroll
    for (int i = 0; i < 2; ++i) { stage_rc(tid * 16 + i * 8192, Rr[i], Cc[i]); const int Rb = Epi::PERM ? ((Rr[i] & ~31) + perm32(Rr[i] & 31)) : Rr[i]; voffB[i] = (unsigned)(Rb * RB + Cc[i] * 2); }
    const size_t kstep = (size_t)(BK * 2);
    const size_t hstep = (size_t)HALF * RB;
    const unsigned ldsw = (unsigned)wid * 1024u;
    const int aoff = lds_byte(wr * 64 + fr, fq * 8), boff = lds_byte(wc * 32 + fr, fq * 8);
#define PG8_SA(b, h) (((b) * 2 + (h)) * HTB)
#define PG8_SB(b, h) ((4 + (b) * 2 + (h)) * HTB)
#define PG8_STAGE(bufoff, gbase, voff) do { _Pragma("unroll") for (int _i = 0; _i < 2; ++_i) { unsigned _o = (voff)[_i]; asm volatile("" : "+v"(_o));     \
        __builtin_amdgcn_global_load_lds((const unsigned*)((const char*)(gbase) + _o), (LAS unsigned*)(lds + (bufoff) + ldsw + _i * 8192), 16, 0, 0); } } while (0)
#define PG8_LDA(dst, b, h) do { _Pragma("unroll") for (int m = 0; m < 4; ++m) _Pragma("unroll") for (int k = 0; k < 2; ++k) dst[m][k] = *(const LAS bf16x8*)(lds + PG8_SA(b, h) + aoff + m * 2048 + k * 1024); } while (0)
#define PG8_LDB(dst, b, h) do { _Pragma("unroll") for (int n = 0; n < 2; ++n) _Pragma("unroll") for (int k = 0; k < 2; ++k) dst[n][k] = *(const LAS bf16x8*)(lds + PG8_SB(b, h) + boff + n * 2048 + k * 1024); } while (0)
#define PG8_CAT(x) __builtin_shufflevector(__builtin_bit_cast(u32x4, (x)[0]), __builtin_bit_cast(u32x4, (x)[1]), 0, 1, 2, 3, 4, 5, 6, 7)
#define PG8_MMA(ai, bj, At, Bt) do { __builtin_amdgcn_s_setprio(1); \
        if constexpr (FP8) { _Pragma("unroll") for (int m = 0; m < 4; ++m) _Pragma("unroll") for (int n = 0; n < 2; ++n) \
            acc[ai][bj][m][n] = __builtin_amdgcn_mfma_scale_f32_16x16x128_f8f6f4(__builtin_bit_cast(v8i32, PG8_CAT(Bt[n])), __builtin_bit_cast(v8i32, PG8_CAT(At[m])), acc[ai][bj][m][n], 0, 0, 0, 0x7f7f7f7f, 0, 0x7f7f7f7f); } \
        else { _Pragma("unroll") for (int m = 0; m < 4; ++m) _Pragma("unroll") for (int n = 0; n < 2; ++n) _Pragma("unroll") for (int k = 0; k < 2; ++k) \
            acc[ai][bj][m][n] = __builtin_amdgcn_mfma_f32_16x16x32_bf16(Bt[n][k], At[m][k], acc[ai][bj][m][n], 0, 0, 0); } \
        __builtin_amdgcn_s_setprio(0); } while (0)
#define PG8_WAIT_V(n) asm volatile("s_waitcnt vmcnt(" #n ")" ::: "memory")
#define PG8_WAIT_VR(rl) do { if constexpr (Epi::NST > 0) { if (rl) asm volatile("s_waitcnt vmcnt(%0)" :: "n"(8 + Epi::NST) : "memory"); else PG8_WAIT_V(8); } else PG8_WAIT_V(8); } while (0)
#define PG8_WAIT_L(n) asm volatile("s_waitcnt lgkmcnt(" #n ")" ::: "memory")
#define PG8_BAR __builtin_amdgcn_s_barrier()
#define PG8_SCHED __builtin_amdgcn_sched_barrier(0)
    Unit cur, nxt; int ui = 0;
    if (!S.next(0, cur)) return;
    f32x4 acc[2][2][4][2];
#pragma unroll
    for (int a = 0; a < 2; ++a)
#pragma unroll
        for (int b = 0; b < 2; ++b)
#pragma unroll
            for (int m = 0; m < 4; ++m)
#pragma unroll
                for (int n = 0; n < 2; ++n) acc[a][b][m][n] = (f32x4){0.f, 0.f, 0.f, 0.f};
    bf16x8 At[4][2], B0[2][2], B1[2][2];
    const char* cA = S.a_base(cur); const char* cB = S.b_base(cur);
    unsigned vA[2][2];
    S.a_off(cur, Rr, Cc, vA);
    PG8_STAGE(PG8_SB(0, 0), cB, voffB); PG8_STAGE(PG8_SB(0, 1), cB + hstep, voffB); PG8_STAGE(PG8_SA(0, 0), cA, vA[0]); PG8_STAGE(PG8_SA(0, 1), cA, vA[1]);
    if (wr == 1) PG8_BAR;
    PG8_WAIT_V(2); PG8_BAR;
    PG8_STAGE(PG8_SB(1, 0), cB + kstep, voffB); PG8_STAGE(PG8_SA(1, 0), cA + kstep, vA[0]); PG8_STAGE(PG8_SB(1, 1), cB + hstep + kstep, voffB);
    PG8_WAIT_V(6); PG8_BAR;
    for (;;) {
        const bool has_next = S.next(ui + 1, nxt);
        const char* nA = cA; const char* nB = cB;
        S.prefetch_cur(cur, wid, lane);
        if (has_next) { nA = S.a_base(nxt); nB = S.b_base(nxt); S.prefetch(nxt, ui + 1, wid, lane); }
#pragma unroll 1
        for (int t = 0; t < nt; t += 2) {
            const bool last = (t == nt - 2);
            const bool relax = (t == 0) && (ui > 0);
            const char* a1 = cA + (size_t)(t + 1) * kstep;
            const char* a2 = last ? nA : cA + (size_t)(t + 2) * kstep; const char* b2 = last ? nB : cB + (size_t)(t + 2) * kstep;
            const char* a3 = a2 + kstep; const char* b3 = b2 + kstep;
            PG8_LDB(B0, 0, 0); PG8_LDB(B1, 0, 1); PG8_SCHED; PG8_LDA(At, 0, 0); PG8_STAGE(PG8_SA(1, 1), a1, vA[1]);
            if (last && has_next) S.a_off_late(nxt, ui + 1, Rr, Cc, vA);
            PG8_WAIT_VR(relax); PG8_WAIT_L(0); PG8_BAR; PG8_MMA(0, 0, At, B0); PG8_MMA(0, 1, At, B1); PG8_BAR; PG8_SCHED;
            PG8_LDA(At, 0, 1); PG8_STAGE(PG8_SB(0, 0), b2, voffB); PG8_STAGE(PG8_SB(0, 1), b2 + hstep, voffB); PG8_STAGE(PG8_SA(0, 0), a2, vA[0]);
            PG8_WAIT_VR(relax); PG8_WAIT_L(0); PG8_BAR; PG8_MMA(1, 0, At, B0); PG8_MMA(1, 1, At, B1); PG8_BAR; PG8_SCHED;
            PG8_LDB(B0, 1, 0); PG8_LDB(B1, 1, 1); PG8_SCHED; PG8_LDA(At, 1, 0); PG8_STAGE(PG8_SA(0, 1), a2, vA[1]);
            PG8_WAIT_V(8); PG8_WAIT_L(0); PG8_BAR; PG8_MMA(0, 0, At, B0); PG8_MMA(0, 1, At, B1); PG8_BAR; PG8_SCHED;
            PG8_LDA(At, 1, 1); PG8_STAGE(PG8_SB(1, 0), b3, voffB); PG8_STAGE(PG8_SB(1, 1), b3 + hstep, voffB); PG8_STAGE(PG8_SA(1, 0), a3, vA[0]);
            PG8_WAIT_V(8); PG8_WAIT_L(0); PG8_BAR; PG8_MMA(1, 0, At, B0); PG8_MMA(1, 1, At, B1); PG8_BAR; PG8_SCHED;
        }
        if (wr == 0) PG8_BAR;
        E(acc, cur, wr, wc, fr, fq);
        if (!has_next) break;
#pragma unroll
        for (int a = 0; a < 2; ++a)
#pragma unroll
            for (int b = 0; b < 2; ++b)
#pragma unroll
                for (int m = 0; m < 4; ++m)
#pragma unroll
                    for (int n = 0; n < 2; ++n) acc[a][b][m][n] = (f32x4){0.f, 0.f, 0.f, 0.f};
        cur = nxt; cA = nA; cB = nB; ++ui;
        if (wr == 1) PG8_BAR;
    }
    PG8_WAIT_V(0);
    PG8_BAR;
#undef PG8_SA
#undef PG8_SB
#undef PG8_STAGE
#undef PG8_LDA
#undef PG8_LDB
#undef PG8_MMA
#undef PG8_CAT
#undef PG8_WAIT_V
#undef PG8_WAIT_L
#undef PG8_BAR
#undef PG8_SCHED
}
}
typedef pg8::Unit Unit;
#define EPI_ROWS(ai, m) (128 * (ai) + 64 * wr + 16 * (m) + fr)

constexpr float WSCALE = 64.f, WSCALE_INV = 1.f / 64.f;
__device__ __forceinline__ unsigned pk4_fp8(float a, float b, float c, float d) { unsigned w = 0u; w = __builtin_amdgcn_cvt_pk_fp8_f32(a, b, w, false); w = __builtin_amdgcn_cvt_pk_fp8_f32(c, d, w, true); return w; }
__device__ __forceinline__ u32x4 pack8(const f32x4& a, const f32x4& b) { u32x4 w; w.x = cvtpk(a[0], a[1]); w.y = cvtpk(a[2], a[3]); w.z = cvtpk(b[0], b[1]); w.w = cvtpk(b[2], b[3]); return w; }

struct EpiInProj {
    static constexpr bool PERM = true; static constexpr int NST = 16;
    unsigned char* ws; const LAS float* bgate; const LAS float* qgain; const LAS float* kgain;
    __device__ __forceinline__ void operator()(const f32x4 (&acc)[2][2][4][2], const Unit& u, int wr, int wc, int fr, int fq) const {
        const int tile = u.pn; const size_t row0 = (size_t)u.pm * 256;
        if (tile == 4) {
            float* GA = (float*)(ws + WS_GA);
#pragma unroll
            for (int bj = 0; bj < 2; ++bj) { const int col = 128 * bj + 32 * wc + 8 * fq;
                const f32x4 b0 = *(const LAS f32x4*)(bgate + col), b1 = *(const LAS f32x4*)(bgate + col + 4);
#pragma unroll
                for (int ai = 0; ai < 2; ++ai)
#pragma unroll
                    for (int m = 0; m < 4; ++m) { f32x4 v0 = acc[ai][bj][m][0] + b0, v1 = acc[ai][bj][m][1] + b1;
#pragma unroll
                        for (int i = 0; i < 4; ++i) { v0[i] = (fminf(v0[i], 0.f) - __logf(1.f + __expf(-fabsf(v0[i])))) * 0.0625f; v1[i] = (fminf(v1[i], 0.f) - __logf(1.f + __expf(-fabsf(v1[i])))) * 0.0625f; }
                        float* p = GA + (row0 + EPI_ROWS(ai, m)) * 256 + col; *(f32x4*)p = v0; *(f32x4*)(p + 4) = v1; } }
        } else if (tile >= 7 && tile <= 10) {
            const bool isq = tile <= 8; const LAS float* gn = isq ? qgain : kgain; const float osc = isq ? 0.125f * LOG2E : 1.0f;
            bf16_t* O = (bf16_t*)(ws + (isq ? WS_DQ : WS_DK)); const int tl = (tile - 7) & 1;
            f32x4 g[2][2];
#pragma unroll
            for (int bj = 0; bj < 2; ++bj)
#pragma unroll
                for (int n = 0; n < 2; ++n) g[bj][n] = *(const LAS f32x4*)(gn + 32 * bj + 8 * fq + 4 * n) * osc;
#pragma unroll
            for (int ai = 0; ai < 2; ++ai)
#pragma unroll
                for (int m = 0; m < 4; ++m) { float ss = 0.f;
#pragma unroll
                    for (int bj = 0; bj < 2; ++bj)
#pragma unroll
                        for (int n = 0; n < 2; ++n) { const f32x4 x = acc[ai][bj][m][n]; ss += (x[0] * x[0] + x[1] * x[1]) + (x[2] * x[2] + x[3] * x[3]); }
                    ss += __shfl_xor(ss, 16); ss += __shfl_xor(ss, 32);
                    const float rs = __builtin_amdgcn_rsqf(ss * (1.f / 64.f) + EPS);
                    bf16_t* p = O + (row0 + EPI_ROWS(ai, m)) * 512 + tl * 256 + 64 * wc + 8 * fq;
#pragma unroll
                    for (int bj = 0; bj < 2; ++bj) *(u32x4*)(p + 32 * bj) = pack8(acc[ai][bj][m][0] * rs * g[bj][0], acc[ai][bj][m][1] * rs * g[bj][1]); }
        } else {
            size_t base; int ld, c0; float sc = 1.f; bool silu = false;
            if (tile == 0) { base = WS_GQ; ld = 256; c0 = 0; sc = 0.125f; }
            else if (tile == 1) { base = WS_GK; ld = 256; c0 = 0; }
            else if (tile <= 3) { base = WS_GV; ld = 512; c0 = (tile - 2) * 256; }
            else if (tile <= 6) { base = WS_GR; ld = 512; c0 = (tile - 5) * 256; silu = true; }
            else { base = WS_DV; ld = 512; c0 = (tile - 11) * 256; }
            bf16_t* O = (bf16_t*)(ws + base);
#pragma unroll
            for (int ai = 0; ai < 2; ++ai)
#pragma unroll
                for (int m = 0; m < 4; ++m) { bf16_t* p = O + (row0 + EPI_ROWS(ai, m)) * ld + c0 + 32 * wc + 8 * fq;
#pragma unroll
                    for (int bj = 0; bj < 2; ++bj) { f32x4 v0 = acc[ai][bj][m][0], v1 = acc[ai][bj][m][1];
                        if (silu) {
#pragma unroll
                            for (int hp = 0; hp < 2; ++hp) { f32x2 a = {v0[2 * hp], v0[2 * hp + 1]}, b = {v1[2 * hp], v1[2 * hp + 1]};
                                const f32x2 ta = a * (-LOG2E), tb = b * (-LOG2E); f32x2 ea, eb; ea.x = fast_exp2(ta.x); ea.y = fast_exp2(ta.y); eb.x = fast_exp2(tb.x); eb.y = fast_exp2(tb.y);
                                const f32x2 da = ea + 1.0f, db = eb + 1.0f; f32x2 ra, rb; ra.x = fast_rcp(da.x); ra.y = fast_rcp(da.y); rb.x = fast_rcp(db.x); rb.y = fast_rcp(db.y);
                                a = a * ra; b = b * rb; v0[2 * hp] = a.x; v0[2 * hp + 1] = a.y; v1[2 * hp] = b.x; v1[2 * hp + 1] = b.y; } }
                        else if (tile == 0) { v0 = v0 * sc; v1 = v1 * sc; }
                        *(u32x4*)(p + 128 * bj) = pack8(v0, v1); } }
        }
    }
};

struct EpiResid {
    static constexpr bool PERM = true; static constexpr int NST = 16;
    const float* x; float* out;
    __device__ __forceinline__ void operator()(const f32x4 (&acc)[2][2][4][2], const Unit& u, int wr, int wc, int fr, int fq) const {
        asm volatile("" : "+v"(fr), "+v"(fq));
        const float* __restrict__ xb = x; float* __restrict__ ob = out;
#pragma unroll
        for (int bj = 0; bj < 2; ++bj) { f32x4 xv[2][4][2];
#pragma unroll
            for (int ai = 0; ai < 2; ++ai)
#pragma unroll
                for (int m = 0; m < 4; ++m) { const float* xp = xb + ((size_t)u.pm * 256 + EPI_ROWS(ai, m)) * DM + (size_t)u.pn * 256 + 128 * bj + 32 * wc + 8 * fq; xv[ai][m][0] = *(const f32x4*)xp; xv[ai][m][1] = *(const f32x4*)(xp + 4); }
            asm volatile("" ::: "memory");
#pragma unroll
            for (int ai = 0; ai < 2; ++ai)
#pragma unroll
                for (int m = 0; m < 4; ++m) { float* op = ob + ((size_t)u.pm * 256 + EPI_ROWS(ai, m)) * DM + (size_t)u.pn * 256 + 128 * bj + 32 * wc + 8 * fq;
                    *(f32x4*)op = xv[ai][m][0] + acc[ai][bj][m][0]; *(f32x4*)(op + 4) = xv[ai][m][1] + acc[ai][bj][m][1]; }
            asm volatile("" ::: "memory"); }
    }
};

struct EpiGateUp {
    static constexpr bool PERM = true; static constexpr int NST = 0;
    unsigned char* hid; const LAS float* bls; const LAS float* lrs;
    static __device__ __forceinline__ f32x2 act2(f32x2 accg, f32x2 accl, f32x2 bg, f32x2 bl, float sc) {
        const f32x2 g = accg * sc + bg, l = accl * sc + bl;
        f32x2 a; a.x = fminf(g.x, 7.f); a.y = fminf(g.y, 7.f);
        const f32x2 t = a * (-1.702f * LOG2E);
        f32x2 e; e.x = fast_exp2(t.x); e.y = fast_exp2(t.y);
        const f32x2 d = e + 1.0f;
        f32x2 r; r.x = fast_rcp(d.x); r.y = fast_rcp(d.y);
        f32x2 lc; lc.x = __builtin_amdgcn_fmed3f(l.x, -7.f, 7.f); lc.y = __builtin_amdgcn_fmed3f(l.y, -7.f, 7.f);
        const f32x2 ar = a * r;
        return ar * lc + ar;
    }
    __device__ __forceinline__ void operator()(const f32x4 (&acc)[2][2][4][2], const Unit& u, int wr, int wc, int fr, int fq) const {
        asm volatile("" : "+v"(fr), "+v"(fq));
        const int nt = u.pn & 7, hc = nt * 128 + 32 * wc + 8 * fq;
        const LAS float* bp = bls + (u.par ? 768 : 0) + 32 * wc + 8 * fq;
        const f32x4 bg0 = *(const LAS f32x4*)bp, bg1 = *(const LAS f32x4*)(bp + 4), bl0 = *(const LAS f32x4*)(bp + 128), bl1 = *(const LAS f32x4*)(bp + 132);
        float rsc[2][4];
#pragma unroll
        for (int ai = 0; ai < 2; ++ai)
#pragma unroll
            for (int m = 0; m < 4; ++m) { const int rl = EPI_ROWS(ai, m); rsc[ai][m] = lrs[u.par * 256 + rl] * WSCALE_INV; }
#pragma unroll
        for (int ai = 0; ai < 2; ++ai)
#pragma unroll
            for (int m = 0; m < 4; ++m) { const int rl = EPI_ROWS(ai, m); const float sc = rsc[ai][m];
                const f32x4 G0 = acc[ai][0][m][0], G1 = acc[ai][0][m][1], L0 = acc[ai][1][m][0], L1 = acc[ai][1][m][1];
                const f32x2 h0 = act2((f32x2){G0[0], G0[1]}, (f32x2){L0[0], L0[1]}, (f32x2){bg0[0], bg0[1]}, (f32x2){bl0[0], bl0[1]}, sc);
                const f32x2 h1 = act2((f32x2){G0[2], G0[3]}, (f32x2){L0[2], L0[3]}, (f32x2){bg0[2], bg0[3]}, (f32x2){bl0[2], bl0[3]}, sc);
                const f32x2 h2 = act2((f32x2){G1[0], G1[1]}, (f32x2){L1[0], L1[1]}, (f32x2){bg1[0], bg1[1]}, (f32x2){bl1[0], bl1[1]}, sc);
                const f32x2 h3 = act2((f32x2){G1[2], G1[3]}, (f32x2){L1[2], L1[3]}, (f32x2){bg1[2], bg1[3]}, (f32x2){bl1[2], bl1[3]}, sc);
                if (rl < u.rows) { u32x2 w; w.x = pk4_fp8(h0.x, h0.y, h1.x, h1.y); w.y = pk4_fp8(h2.x, h2.y, h3.x, h3.y); *(u32x2*)(hid + ((size_t)u.row0 + rl) * DFF + hc) = w; } }
    }
};

constexpr float YSCALE = 16.f, YSCALE_INV = 1.f / 16.f;
struct EpiDown {
    static constexpr bool PERM = true; static constexpr int NST = 0;
    unsigned char* ws; const LAS float* bls; const LAS int* dls; const LAS float* gls;
    __device__ __forceinline__ void operator()(const f32x4 (&acc)[2][2][4][2], const Unit& u, int wr, int wc, int fr, int fq) const {
        asm volatile("" : "+v"(fr), "+v"(fq));
        const int nt = u.pn & 3;
        int dst[2][4]; float gt[2][4];
#pragma unroll
        for (int ai = 0; ai < 2; ++ai)
#pragma unroll
            for (int m = 0; m < 4; ++m) { const int rl = EPI_ROWS(ai, m); dst[ai][m] = dls[u.par * 256 + rl]; gt[ai][m] = gls[u.par * 256 + rl]; }
#pragma unroll
        for (int bj = 0; bj < 2; ++bj) { const size_t col = (size_t)nt * 256 + 128 * bj + 32 * wc + 8 * fq;
            const LAS float* bp = bls + (u.par ? 768 : 0) + 128 * bj + 32 * wc + 8 * fq; const f32x4 b0 = *(const LAS f32x4*)bp, b1 = *(const LAS f32x4*)(bp + 4);
#pragma unroll
            for (int ai = 0; ai < 2; ++ai)
#pragma unroll
                for (int m = 0; m < 4; ++m) { const int rl = EPI_ROWS(ai, m); const int tok = dst[ai][m] >> 2, k = dst[ai][m] & 3; const float g = gt[ai][m] * YSCALE;
                    const f32x4 y0 = (acc[ai][bj][m][0] * WSCALE_INV + b0) * g, y1 = (acc[ai][bj][m][1] * WSCALE_INV + b1) * g;
                    const size_t yb = k == 0 ? WS_YS0 : (k == 1 ? WS_YS1 : (k == 2 ? WS_YS2 : WS_YS3));
                    if (rl < u.rows) { u32x2 wv; wv.x = pk4_fp8(y0[0], y0[1], y0[2], y0[3]); wv.y = pk4_fp8(y1[0], y1[1], y1[2], y1[3]); *(u32x2*)(ws + yb + (size_t)tok * DM + col) = wv; } }
        }
    }
};
struct MoeOrder {
    const LAS int* tab;
    int G, c, NTs, gather;
    const char* A; const char* Bt; const int* ldst; const float* lrs; const float* lgate; const float* bias;
    __device__ __forceinline__ int rd(int i) const { return __builtin_amdgcn_readfirstlane(tab[i]); }
    __device__ __forceinline__ bool next(int i, Unit& u) const {
        const int g = i * G + c, MT = rd(32);
        if (g >= (MT << NTs)) return false;
        const int mtg = g >> NTs, nt = g & ((1 << NTs) - 1);
        const int info = rd(128 + 2 * mtg), row0 = rd(129 + 2 * mtg);
        const int e = info & 31, mt = (info >> 5) & 511;
        u.e = e; u.pm = mt; u.pn = (e << NTs) + nt; u.rows = info >> 14; u.row0 = row0; u.lst = e * 65536 + mt * 256; u.par = i & 1;
        return true;
    }
    __device__ __forceinline__ const char* a_base(const Unit& u) const { return gather ? A : A + (size_t)u.row0 * (size_t)DM; }
    __device__ __forceinline__ const char* b_base(const Unit& u) const { return Bt + (size_t)u.pn * (size_t)256 * DM; }
    __device__ __forceinline__ void a_off(const Unit& u, const int (&R)[2], const int (&C)[2], unsigned (&o)[2][2]) const {
#pragma unroll
        for (int h = 0; h < 2; ++h)
#pragma unroll
            for (int i = 0; i < 2; ++i) { const int rl = h * 128 + R[i];
                if (gather) { const int tok = ldst[u.lst + (rl < u.rows ? rl : 0)] >> 2; o[h][i] = (unsigned)(tok * DM + C[i] * 2); }
                else o[h][i] = (unsigned)(rl * DM + C[i] * 2); }
        if (gather) {
#pragma unroll
            for (int h = 0; h < 2; ++h)
#pragma unroll
                for (int i = 0; i < 2; ++i) asm volatile("" : "+v"(o[h][i])); }
    }
    __device__ __forceinline__ void prefetch(const Unit& u, int ui, int wid, int lane) const {
        if (gather && wid < 4) { const unsigned dst = (unsigned)(uintptr_t)tab + 12288u + (unsigned)(ui & 1) * 1024u + (unsigned)wid * 256u, voff = (unsigned)(u.lst + wid * 64 + lane) * 4u; unsigned keep;
            asm volatile("s_mov_b32 %0, m0\n\ts_mov_b32 m0, %3\n\ts_nop 0\n\tglobal_load_lds_dword %1, %2\n\ts_mov_b32 m0, %0" : "=&s"(keep) : "v"(voff), "s"(ldst), "s"(dst) : "memory"); }
    }
    __device__ __forceinline__ void prefetch_cur(const Unit& u, int wid, int lane) const {
        if (gather && wid >= 4) { const unsigned dst = (unsigned)(uintptr_t)tab + 9216u + (unsigned)u.par * 1024u + (unsigned)(wid - 4) * 256u, voff = (unsigned)(u.lst + (wid - 4) * 64 + lane) * 4u; unsigned keep;
            asm volatile("s_mov_b32 %0, m0\n\ts_mov_b32 m0, %3\n\ts_nop 0\n\tglobal_load_lds_dword %1, %2\n\ts_mov_b32 m0, %0" : "=&s"(keep) : "v"(voff), "s"(lrs), "s"(dst) : "memory"); }
        { const int q = wid & 3, nt = u.pn & ((1 << NTs) - 1);
            const unsigned dstb = (unsigned)(uintptr_t)tab + (u.par ? 14336u : 11264u) + (unsigned)q * 256u; unsigned keep;
            const unsigned voffb = gather ? (unsigned)(u.e * 2048 + (q >> 1) * 1024 + nt * 128 + (q & 1) * 64 + lane) * 4u : (unsigned)(u.e * 1024 + nt * 256 + q * 64 + lane) * 4u;
            if (gather ? wid >= 4 : wid < 4) asm volatile("s_mov_b32 %0, m0\n\ts_mov_b32 m0, %3\n\ts_nop 0\n\tglobal_load_lds_dword %1, %2\n\ts_mov_b32 m0, %0" : "=&s"(keep) : "v"(voffb), "s"(bias), "s"(dstb) : "memory"); }
        if (!gather) { const void* src = wid < 4 ? (const void*)ldst : (const void*)lgate; const int q = wid & 3;
            const unsigned dst = (unsigned)(uintptr_t)tab + (wid < 4 ? 9216u : 12288u) + (unsigned)u.par * 1024u + (unsigned)q * 256u, voff = (unsigned)(u.lst + q * 64 + lane) * 4u; unsigned keep;
            asm volatile("s_mov_b32 %0, m0\n\ts_mov_b32 m0, %3\n\ts_nop 0\n\tglobal_load_lds_dword %1, %2\n\ts_mov_b32 m0, %0" : "=&s"(keep) : "v"(voff), "s"(src), "s"(dst) : "memory"); }
    }
    __device__ __forceinline__ void a_off_late(const Unit& u, int ui, const int (&R)[2], const int (&C)[2], unsigned (&o)[2][2]) const {
        const LAS int* tb = tab + 3072 + (ui & 1) * 256;
#pragma unroll
        for (int h = 0; h < 2; ++h)
#pragma unroll
            for (int i = 0; i < 2; ++i) { const int rl = h * 128 + R[i];
                if (gather) { const int tok = tb[rl < u.rows ? rl : 0] >> 2; o[h][i] = (unsigned)(tok * DM + C[i] * 2); }
                else o[h][i] = (unsigned)(rl * DM + C[i] * 2); }
    }
};
#define XB_TMO      128
#define XB_XCNT(j)  (256  + 64 * (j))
#define XB_XSUB(j)  (1280 + 64 * (j))
#define XB_XGEN(j)  (2304 + 64 * (j))
#define XB_TOP      3328
#define XB_TOPGEN   3392
#define XCD_BAR_WORDS 3456
#define XB_SPIN_CAP (1u << 18)

__device__ __forceinline__ unsigned xb_ld(unsigned* p)              { return __hip_atomic_load(p, __ATOMIC_RELAXED, __HIP_MEMORY_SCOPE_AGENT); }
__device__ __forceinline__ unsigned xb_add(unsigned* p, unsigned v) { return __hip_atomic_fetch_add(p, v, __ATOMIC_RELAXED, __HIP_MEMORY_SCOPE_AGENT); }
__device__ __forceinline__ unsigned xb_xcc_id() { return (unsigned)__builtin_amdgcn_s_getreg((3 << 11) | 20) & 0xFu; }
#define XB_SPIN(cond, bar) do { unsigned _sp = 0; while (cond) { __builtin_amdgcn_s_sleep(1); \
    if ((++_sp & 255u) == 0u) { if (xb_ld(&(bar)[XB_TMO])) break; if (_sp > XB_SPIN_CAP) { atomicAdd(&(bar)[XB_TMO], 1u); break; } } } } while (0)

struct XcdBarrier {
    unsigned* bar; unsigned x; int wave;
    volatile LAS unsigned* st;
};

__device__ __forceinline__ XcdBarrier xcd_barrier_post(unsigned* bar, volatile LAS unsigned* st, int wave) {
    XcdBarrier b; b.bar = bar; b.x = xb_xcc_id(); b.st = st; b.wave = wave;
    if (wave == 0 && lane_id() == 0) (void)xb_add(&bar[XB_XCNT(b.x)], 1u);
    return b;
}
__device__ __forceinline__ void xcd_barrier_complete(unsigned* bar, unsigned x, unsigned& nloc, unsigned& nx) {
    const unsigned G = gridDim.x * gridDim.y * gridDim.z;
    unsigned sum, cnt, mine, sp = 0u;
    for (;;) {
        sum = 0u; cnt = 0u; mine = 0u;
#pragma unroll
        for (unsigned j = 0; j < 16; ++j) { const unsigned c = xb_ld(&bar[XB_XCNT(j)]); sum += c; cnt += (c > 0u) ? 1u : 0u; mine = (j == x) ? c : mine; }
        if (sum == G) break;
        __builtin_amdgcn_s_sleep(1);
        if ((++sp & 255u) == 0u) { if (xb_ld(&bar[XB_TMO])) break; if (sp > XB_SPIN_CAP) { atomicAdd(&bar[XB_TMO], 1u); break; } }
    }
    nloc = mine > 0u ? mine : 1u; nx = cnt > 0u ? cnt : 1u;
}

__device__ __forceinline__ void xcd_barrier(const XcdBarrier& b) {
    asm volatile("s_waitcnt vmcnt(0)" ::: "memory");
    __syncthreads();
    if (b.wave == 0 && lane_id() == 0) {
        unsigned* bar = b.bar;
        __builtin_amdgcn_s_waitcnt(0);
        unsigned nloc = b.st[0], nx = b.st[1];
        if (nloc == 0u) { xcd_barrier_complete(bar, b.x, nloc, nx); b.st[0] = nloc; b.st[1] = nx; }
        const unsigned old = xb_add(&bar[XB_XSUB(b.x)], 1u);
        const unsigned gen = old / nloc;
        if (old + 1u == (gen + 1u) * nloc) {
            __builtin_amdgcn_fence(__ATOMIC_RELEASE, "agent");
            asm volatile("s_waitcnt vmcnt(0)" ::: "memory");
            const unsigned og = xb_add(&bar[XB_TOP], 1u);
            const unsigned tg = og / nx;
            if (og + 1u == (tg + 1u) * nx) xb_add(&bar[XB_TOPGEN], 1u);
            else XB_SPIN(xb_ld(&bar[XB_TOPGEN]) == tg, bar);
            __builtin_amdgcn_fence(__ATOMIC_ACQUIRE, "agent");
            xb_add(&bar[XB_XGEN(b.x)], 1u);
            asm volatile("s_waitcnt vmcnt(0)" ::: "memory");
        } else {
            XB_SPIN(xb_ld(&bar[XB_XGEN(b.x)]) == gen, bar);
            __builtin_amdgcn_fence(__ATOMIC_ACQUIRE, "agent");
            asm volatile("s_waitcnt vmcnt(0)" ::: "memory");
        }
    }
    __syncthreads();
}
struct Frame {
    LAS unsigned char* lds;
    gu32* ctl;
    int wave, vcu, G;
    const float* in[22]; float* out; unsigned char* ws;
};
enum { I_X = 0, I_N1G, I_WIN, I_WG2, I_BG2, I_GOG, I_QG, I_KG, I_LQ1, I_LK1, I_LQ2, I_LK2, I_SUBG, I_RELB, I_WOUT, I_N2G, I_WR, I_BR, I_WGU, I_BGU, I_WD, I_BD };

__device__ __forceinline__ s16x4 tr4(const LAS unsigned char* p) { return __builtin_bit_cast(s16x4, __builtin_amdgcn_ds_read_tr16_b64_v4i16((LAS s16x4*)p)); }
__device__ __forceinline__ bf16x8 cat8(s16x4 lo, s16x4 hi) { return __builtin_shufflevector(lo, hi, 0, 1, 2, 3, 4, 5, 6, 7); }
__device__ __forceinline__ int crow(int r, int hi) { return (r & 3) + 8 * (r >> 2) + 4 * hi; }
#define MFMA32(a, b, c) __builtin_amdgcn_mfma_f32_32x32x16_bf16((a), (b), (c), 0, 0, 0)
__device__ __forceinline__ float swap32(float v) { return __shfl_xor(v, 32); }
__device__ __forceinline__ bf16x8 pack_step(const f32x16& x, int s) {
    u32x4 p; p.x = cvtpk(x[8 * s], x[8 * s + 1]); p.y = cvtpk(x[8 * s + 2], x[8 * s + 3]); p.z = cvtpk(x[8 * s + 4], x[8 * s + 5]); p.w = cvtpk(x[8 * s + 6], x[8 * s + 7]);
    return __builtin_bit_cast(bf16x8, p);
}

__device__ __forceinline__ void p0_tr64(const float* W, int ldw, int ca, int cb, int k0, bf16_t* WT, size_t dst_row0, LAS float* scr, int lane) {
    const int sc = (lane & 32) ? cb + (lane & 31) : ca + (lane & 31);
    const float* src = W + (size_t)k0 * ldw + sc;
#pragma unroll 16
    for (int i = 0; i < 64; ++i) scr[i * 65 + lane] = src[(size_t)i * ldw];
    LDS_WAIT();
    const int c = lane & 7;
#pragma unroll
    for (int j = 0; j < 8; ++j) { const int n = (lane >> 3) + 8 * j; const LAS float* s = scr + (8 * c) * 65 + n;
        u32x4 o; o.x = cvtpk(s[0], s[65]); o.y = cvtpk(s[130], s[195]); o.z = cvtpk(s[260], s[325]); o.w = cvtpk(s[390], s[455]);
        *(u32x4*)(WT + (dst_row0 + n) * 1024 + k0 + 8 * c) = o; }
    LDS_WAIT();
}
__device__ __forceinline__ void p0_tr64_fp8(const float* W, int ldw, int ca, int k0, unsigned char* WT, size_t dst_row0, LAS float* scr, int lane) {
    const float* src = W + (size_t)k0 * ldw + ca + lane;
#pragma unroll 16
    for (int i = 0; i < 64; ++i) scr[i * 65 + lane] = src[(size_t)i * ldw];
    LDS_WAIT();
    const int c = lane & 3;
#pragma unroll
    for (int j = 0; j < 4; ++j) { const int n = (lane >> 2) + 16 * j; const LAS float* s = scr + (16 * c) * 65 + n;
        u32x4 o;
        o.x = pk4_fp8(s[0] * WSCALE, s[65] * WSCALE, s[130] * WSCALE, s[195] * WSCALE); o.y = pk4_fp8(s[260] * WSCALE, s[325] * WSCALE, s[390] * WSCALE, s[455] * WSCALE);
        o.z = pk4_fp8(s[520] * WSCALE, s[585] * WSCALE, s[650] * WSCALE, s[715] * WSCALE); o.w = pk4_fp8(s[780] * WSCALE, s[845] * WSCALE, s[910] * WSCALE, s[975] * WSCALE);
        *(u32x4*)(WT + (dst_row0 + n) * 1024 + k0 + 16 * c) = o; }
    LDS_WAIT();
}
__device__ __forceinline__ int src32_qk(int d) { return 2 * (d & 3) + (d >> 2); }
__device__ __forceinline__ void p0_prologue(Frame& F) {
    LAS float* scr = (LAS float*)(F.lds + F.wave * 16640);
    const int gw = F.vcu * 8 + F.wave, NGW = F.G * 8;
    constexpr int I_A = 48 * 16, I_B = 16 * 16, NITEMS = I_A + I_B;
    bf16_t* WinT = (bf16_t*)(F.ws + WS_WIN); bf16_t* WoutT = (bf16_t*)(F.ws + WS_WOUT);
    for (int it = gw; it < NITEMS; it += NGW) {
        int r = it;
        if (r < I_A) { const int kb = r & 15, idx = r >> 4, dg = idx < 16 ? idx : idx + 4; int ca, cb;
            if (dg < 16) { ca = 64 * dg; cb = ca + 32; }
            else if (dg < 28) { ca = 1040 + 64 * (dg - 20); cb = ca + 32; }
            else if (dg < 44) { const int tl = (dg - 28) >> 2, up = (dg - 28) & 3, base = tl < 2 ? 1552 + 256 * tl : 2064 + 256 * (tl - 2); ca = base + 32 * src32_qk(2 * up); cb = base + 32 * src32_qk(2 * up + 1); }
            else { ca = 2576 + 64 * (dg - 44); cb = ca + 32; }
            p0_tr64(F.in[I_WIN], 3088, ca, cb, 64 * kb, WinT, (size_t)64 * dg, scr, lane_id()); continue; }
        r -= I_A;
        { const int kb = r & 15, g = r >> 4; p0_tr64(F.in[I_WOUT], 1024, 64 * g, 64 * g + 32, 64 * kb, WoutT, (size_t)64 * g, scr, lane_id()); }
    }
    { const int gt = F.vcu * 512 + (F.wave * 64 + lane_id()), NT_ = F.G * 512; const float* w2 = F.in[I_WG2]; const float* win = F.in[I_WIN];
        for (int idx = gt; idx < 256 * 128; idx += NT_) { const int n = idx & 255, kg = idx >> 8; float wv[16];
#pragma unroll
            for (int r = 0; r < 16; ++r) wv[r] = w2[r * 256 + n];
            float o[8];
#pragma unroll
            for (int kk = 0; kk < 8; ++kk) { const float* wp = win + (size_t)(8 * kg + kk) * 3088 + 1024; float a = 0.f;
#pragma unroll
                for (int r = 0; r < 16; ++r) a += wv[r] * wp[r];
                o[kk] = a; }
            u32x4 w; w.x = cvtpk(o[0], o[1]); w.y = cvtpk(o[2], o[3]); w.z = cvtpk(o[4], o[5]); w.w = cvtpk(o[6], o[7]);
            *(u32x4*)(WinT + (size_t)(1024 + n) * 1024 + 8 * kg) = w; }
        const float* wr_ = F.in[I_WR]; bf16_t* wrf = (bf16_t*)(F.ws + WS_WRF);
        for (int idx = gt; idx < 64 * 64; idx += NT_) { const int ks = idx >> 6, ln = idx & 63, e = ln & 31, hh = ln >> 5; float o[8];
#pragma unroll
            for (int j = 0; j < 8; ++j) o[j] = wr_[(16 * ks + 8 * hh + j) * 32 + e];
            u32x4 w; w.x = cvtpk(o[0], o[1]); w.y = cvtpk(o[2], o[3]); w.z = cvtpk(o[4], o[5]); w.w = cvtpk(o[6], o[7]);
            *(u32x4*)(wrf + (size_t)idx * 8) = w; }
    }
    { const float* x = F.in[I_X]; const float* gn = F.in[I_N1G]; bf16_t* XN = (bf16_t*)(F.ws + WS_XN);
        f32x4 g[4];
#pragma unroll
        for (int j = 0; j < 4; ++j) g[j] = *(const f32x4*)(gn + 4 * lane_id() + 256 * j);
        for (int m0 = gw; m0 < T; m0 += 2 * NGW) { f32x4 v[2][4];
#pragma unroll
            for (int r = 0; r < 2; ++r) { const int m = m0 + r * NGW; if (m < T) { const f32x4* xr = (const f32x4*)(x + (size_t)m * DM) + lane_id();
#pragma unroll
                for (int j = 0; j < 4; ++j) v[r][j] = xr[64 * j]; } }
#pragma unroll
            for (int r = 0; r < 2; ++r) { const int m = m0 + r * NGW; if (m < T) { float s = 0.f;
#pragma unroll
                for (int j = 0; j < 4; ++j) s += (v[r][j].x * v[r][j].x + v[r][j].y * v[r][j].y) + (v[r][j].z * v[r][j].z + v[r][j].w * v[r][j].w);
                const float rs = __builtin_amdgcn_rsqf(wave_sum(s) * (1.f / DM) + EPS);
                u32x2* o8 = (u32x2*)(XN + (size_t)m * DM) + lane_id();
#pragma unroll
                for (int j = 0; j < 4; ++j) { const f32x4 y = v[r][j] * rs * g[j]; u32x2 w; w.x = cvtpk(y.x, y.y); w.y = cvtpk(y.z, y.w); o8[64 * j] = w; } } } }
    }
}

template <bool WB>
__device__ __forceinline__ void gla_g01(Frame& F) {
    LAS unsigned char* L = F.lds;
    LAS float* LA = (LAS float*)L; LAS float* PART = (LAS float*)(L + 16384); LAS unsigned char* KR = L + 18432; LAS unsigned char* VL = L + 27136;
    const float* GA = (const float*)(F.ws + WS_GA); bf16_t* GQ = (bf16_t*)(F.ws + WS_GQ); bf16_t* GK = (bf16_t*)(F.ws + WS_GK); const bf16_t* GV = (const bf16_t*)(F.ws + WS_GV);
    bf16_t* KVS = (bf16_t*)(F.ws + WS_KVS); float* DEC = (float*)(F.ws + WS_DECAY);
    const int tid = (F.wave * 64 + lane_id()), lane = lane_id(), w = F.wave;
    const int d = tid & 63, part = tid >> 6;
    f32x4 ga[2]; u32x4 gv[2]; bf16_t qv[8], kv[8];
#define G01_LOAD(uu) do { const int n_ = (uu) & 127, bh_ = (uu) >> 7, h_ = bh_ & 3, b_ = bh_ >> 2; const size_t r_ = (size_t)b_ * SEQ + 64 * n_; \
        _Pragma("unroll") for (int p = 0; p < 2; ++p) { const int idx = tid + 512 * p, t = idx >> 4, c = idx & 15; ga[p] = *(const f32x4*)(GA + (r_ + t) * 256 + h_ * 64 + 4 * c); gv[p] = *(const u32x4*)(GV + (r_ + t) * 512 + h_ * 128 + 8 * c); } \
        _Pragma("unroll") for (int i = 0; i < 8; ++i) { const size_t gi = (r_ + 8 * part + i) * 256 + h_ * 64 + d; qv[i] = GQ[gi]; kv[i] = GK[gi]; } } while (0)
    if (F.vcu < 4096) G01_LOAD(F.vcu);
    for (int u = F.vcu; u < 4096; u += F.G) {
        const int n = u & 127, bh = u >> 7, h = bh & 3, b = bh >> 2; const size_t row0 = (size_t)b * SEQ + 64 * n;
#pragma unroll
        for (int p = 0; p < 2; ++p) { const int idx = tid + 512 * p, t = idx >> 4, c = idx & 15;
            *(LAS f32x4*)(LA + t * 64 + 4 * c) = ga[p];
            *(LAS u32x4*)(VL + t * 272 + 16 * c) = gv[p]; }
        __syncthreads();
        float cs[8]; float run = 0.f;
#pragma unroll
        for (int i = 0; i < 8; ++i) { run += LA[(8 * part + i) * 64 + d]; cs[i] = run; }
        PART[part * 64 + d] = run;
        __syncthreads();
        float offs = 0.f, tot = 0.f;
#pragma unroll
        for (int p = 0; p < 8; ++p) { const float v = PART[p * 64 + d]; tot += v; if (p < part) offs += v; }
#pragma unroll
        for (int i = 0; i < 8; ++i) { const int t = 8 * part + i; const float bb = offs + cs[i]; const size_t gi = (row0 + t) * 256 + h * 64 + d;
            const float q = bf2f(qv[i]), k = bf2f(kv[i]);
            const float eb = __expf(bb), kd = k * __expf(-bb), kr = k * __expf(tot - bb);
            if (WB) { GQ[gi] = (bf16_t)(cvtpk(q * eb, 0.f) & 0xffffu); GK[gi] = (bf16_t)(cvtpk(kd, 0.f) & 0xffffu); } else { ((bf16_t*)(F.ws + WS_YS2))[gi] = (bf16_t)(cvtpk(q * eb, 0.f) & 0xffffu); ((bf16_t*)(F.ws + WS_YS2 + 33554432))[gi] = (bf16_t)(cvtpk(kd, 0.f) & 0xffffu); }
            *(LAS bf16_t*)(KR + t * 136 + 2 * d) = (bf16_t)(cvtpk(kr, 0.f) & 0xffffu); }
        if (part == 0) DEC[(size_t)u * 64 + d] = __expf(tot);
        __syncthreads();
        if (u + F.G < 4096) G01_LOAD(u + F.G);
        { const int db = w & 1, eb = w >> 1, hh = lane >> 5, blk = (lane >> 4) & 1, q4 = (lane & 15) >> 2, p4 = lane & 3;
            f32x16 acc; for (int i = 0; i < 16; ++i) acc[i] = 0.f;
#pragma unroll
            for (int ks = 0; ks < 4; ++ks) { const int r0 = 16 * ks + 8 * hh + q4;
                const bf16x8 a = cat8(tr4(KR + r0 * 136 + (32 * db + 16 * blk + 4 * p4) * 2), tr4(KR + (r0 + 4) * 136 + (32 * db + 16 * blk + 4 * p4) * 2));
                const bf16x8 bb = cat8(tr4(VL + r0 * 272 + (32 * eb + 16 * blk + 4 * p4) * 2), tr4(VL + (r0 + 4) * 272 + (32 * eb + 16 * blk + 4 * p4) * 2));
                acc = MFMA32(a, bb, acc); }
            bf16_t* o = KVS + ((size_t)u * 64 + 32 * db) * 128 + 32 * eb + (lane & 31);
#pragma unroll
            for (int i = 0; i < 16; ++i) o[(size_t)crow(i, hh) * 128] = (bf16_t)(cvtpk(acc[i], 0.f) & 0xffffu); }
        __syncthreads();
    }
#undef G01_LOAD
}
template <bool REAL>
__device__ __forceinline__ void gla_scan(Frame& F) {
    unsigned* KVS = (unsigned*)(F.ws + WS_KVS); unsigned* KVO = REAL ? KVS : (unsigned*)(F.ws + WS_YS2); const float* DEC = (const float*)(F.ws + WS_DECAY);
    for (int g = F.vcu * 512 + (F.wave * 64 + lane_id()); g < 32 * 64 * 64; g += F.G * 512) { const int e2 = g & 63, d = (g >> 6) & 63, bh = g >> 12;
        float s0 = 0.f, s1 = 0.f;
        for (int n0 = 0; n0 < 128; n0 += 8) { unsigned kv[8]; float dc[8];
#pragma unroll
            for (int i = 0; i < 8; ++i) { const size_t u = (size_t)bh * 128 + n0 + i; kv[i] = KVS[(u * 64 + d) * 64 + e2]; dc[i] = DEC[u * 64 + d]; }
#pragma unroll
            for (int i = 0; i < 8; ++i) { const size_t u = (size_t)bh * 128 + n0 + i; KVO[(u * 64 + d) * 64 + e2] = cvtpk(s0, s1); s0 = s0 * dc[i] + bflo(kv[i]); s1 = s1 * dc[i] + bfhi(kv[i]); } }
    }
}
__device__ __forceinline__ void gla_g3(Frame& F) {
    LAS unsigned char* L = F.lds;
    LAS unsigned char* QD = L; LAS unsigned char* KD = L + 9216; LAS unsigned char* VL = L + 18432; LAS unsigned char* ST = L + 35840; LAS unsigned char* GRs = L + 53248; LAS unsigned char* OUT = L + 70656;
    LAS float* SS = (LAS float*)(L + 88064); LAS float* OG = (LAS float*)(L + 90112);
    const bf16_t* GQ = (const bf16_t*)(F.ws + WS_GQ); const bf16_t* GK = (const bf16_t*)(F.ws + WS_GK); const bf16_t* GV = (const bf16_t*)(F.ws + WS_GV); const bf16_t* GR = (const bf16_t*)(F.ws + WS_GR);
    const bf16_t* KVS = (const bf16_t*)(F.ws + WS_KVS); bf16_t* Y = (bf16_t*)(F.ws + WS_XN);
    { const int t_ = F.wave * 64 + lane_id(); if (t_ < 128) OG[t_] = F.in[I_GOG][t_]; }
    const int tid = (F.wave * 64 + lane_id()), lane = lane_id(), w = F.wave, tb = w & 1, eb = w >> 1, hh = lane >> 5, l31 = lane & 31, blk = (lane >> 4) & 1, q4 = (lane & 15) >> 2, p4 = lane & 3;
    u32x4 pq, pk, pv[2], ps[2], pr[2];
#define G3_LOAD(uu) do { const int n_ = (uu) & 127, bh_ = (uu) >> 7, h_ = bh_ & 3, b_ = bh_ >> 2; const size_t r_ = (size_t)b_ * SEQ + 64 * n_; \
        { const int t = tid >> 3, c = tid & 7; pq = *(const u32x4*)(GQ + (r_ + t) * 256 + h_ * 64 + 8 * c); pk = *(const u32x4*)(GK + (r_ + t) * 256 + h_ * 64 + 8 * c); } \
        _Pragma("unroll") for (int p = 0; p < 2; ++p) { const int idx = tid + 512 * p, t = idx >> 4, c = idx & 15; \
            pv[p] = *(const u32x4*)(GV + (r_ + t) * 512 + h_ * 128 + 8 * c); ps[p] = *(const u32x4*)(KVS + ((size_t)(uu) * 64 + t) * 128 + 8 * c); pr[p] = *(const u32x4*)(GR + (r_ + t) * 512 + h_ * 128 + 8 * c); } } while (0)
    if (F.vcu < 4096) G3_LOAD(F.vcu);
    for (int u = F.vcu; u < 4096; u += F.G) {
        const int n = u & 127, bh = u >> 7, h = bh & 3, b = bh >> 2; const size_t row0 = (size_t)b * SEQ + 64 * n;
        { const int t = tid >> 3, c = tid & 7;
            *(LAS u32x4*)(QD + t * 144 + 16 * c) = pq;
            *(LAS u32x4*)(KD + t * 144 + 16 * c) = pk; }
#pragma unroll
        for (int p = 0; p < 2; ++p) { const int idx = tid + 512 * p, t = idx >> 4, c = idx & 15;
            *(LAS u32x4*)(VL + t * 272 + 16 * c) = pv[p];
            *(LAS u32x4*)(ST + t * 272 + 16 * c) = ps[p];
            *(LAS u32x4*)(GRs + t * 272 + 16 * c) = pr[p]; }
        __syncthreads();
        if (u + F.G < 4096) G3_LOAD(u + F.G);
        bf16x8 qf[4];
#pragma unroll
        for (int ks = 0; ks < 4; ++ks) qf[ks] = *(const LAS bf16x8*)(QD + (32 * tb + l31) * 144 + (16 * ks + 8 * hh) * 2);
        f32x16 o; for (int i = 0; i < 16; ++i) o[i] = 0.f;
#pragma unroll
        for (int sb = 0; sb < 2; ++sb) { f32x16 at; for (int i = 0; i < 16; ++i) at[i] = 0.f;
#pragma unroll
            for (int ks = 0; ks < 4; ++ks) at = MFMA32(*(const LAS bf16x8*)(KD + (32 * sb + l31) * 144 + (16 * ks + 8 * hh) * 2), qf[ks], at);
#pragma unroll
            for (int i = 0; i < 16; ++i) if (32 * sb + crow(i, hh) > 32 * tb + l31) at[i] = 0.f;
#pragma unroll
            for (int s2 = 0; s2 < 2; ++s2) { const int r0 = 32 * sb + 16 * s2 + 4 * hh + q4;
                const bf16x8 va = cat8(tr4(VL + r0 * 272 + (32 * eb + 16 * blk + 4 * p4) * 2), tr4(VL + (r0 + 8) * 272 + (32 * eb + 16 * blk + 4 * p4) * 2));
                o = MFMA32(va, pack_step(at, s2), o); } }
#pragma unroll
        for (int ks = 0; ks < 4; ++ks) { const int r0 = 16 * ks + 8 * hh + q4;
            const bf16x8 sa = cat8(tr4(ST + r0 * 272 + (32 * eb + 16 * blk + 4 * p4) * 2), tr4(ST + (r0 + 4) * 272 + (32 * eb + 16 * blk + 4 * p4) * 2));
            o = MFMA32(sa, qf[ks], o); }
        float ss = 0.f;
#pragma unroll
        for (int i = 0; i < 16; ++i) ss += o[i] * o[i];
        ss += swap32(ss);
        if (hh == 0) SS[eb * 64 + 32 * tb + l31] = ss;
        __syncthreads();
        { const int t = 32 * tb + l31; const float tot = (SS[t] + SS[64 + t]) + (SS[128 + t] + SS[192 + t]); const float rs = __builtin_amdgcn_rsqf(tot * (1.f / 128.f) + EPS);
#pragma unroll
            for (int g4 = 0; g4 < 4; ++g4) { const int e = 32 * eb + 8 * g4 + 4 * hh; const u32x2 rr = *(const LAS u32x2*)(GRs + t * 272 + e * 2); const f32x4 gg = *(const LAS f32x4*)(OG + e);
                u32x2 wv; wv.x = cvtpk(o[4 * g4] * rs * gg[0] * bflo(rr.x), o[4 * g4 + 1] * rs * gg[1] * bfhi(rr.x)); wv.y = cvtpk(o[4 * g4 + 2] * rs * gg[2] * bflo(rr.y), o[4 * g4 + 3] * rs * gg[3] * bfhi(rr.y));
                *(LAS u32x2*)(OUT + t * 272 + e * 2) = wv; } }
        __syncthreads();
#pragma unroll
        for (int p = 0; p < 2; ++p) { const int idx = tid + 512 * p, t = idx >> 4, c = idx & 15;
            *(u32x4*)(Y + (row0 + t) * DM + h * 128 + 8 * c) = *(const LAS u32x4*)(OUT + t * 272 + 16 * c); }
        __syncthreads();
    }
#undef G3_LOAD
}
constexpr int AT_KB = 16384, AT_VB = 16384;
constexpr int AT_K0 = 0, AT_V0 = 3 * AT_KB, AT_XCH = 65536, AT_BIAS = LDS_TAB_OFF, AT_LAM = AT_BIAS + 512, AT_OSTR = 272;
constexpr float AT_THR = 8.f;
__device__ __forceinline__ float max3f(float a, float b, float c) { float r; asm("v_max3_f32 %0, %1, %2, %3" : "=v"(r) : "v"(a), "v"(b), "v"(c)); return r; }
__device__ __forceinline__ float xmax32(float v) { auto rr = __builtin_amdgcn_permlane32_swap(__float_as_uint(v), __float_as_uint(v), false, false); return max3f(__uint_as_float(rr[0]), __uint_as_float(rr[1]), v); }
__device__ __forceinline__ float xsum32(float v) { auto rr = __builtin_amdgcn_permlane32_swap(__float_as_uint(v), __float_as_uint(v), false, false); return __uint_as_float(rr[0]) + __uint_as_float(rr[1]); }
__device__ __forceinline__ void at_dma(const void* gbase, unsigned voff, unsigned lds_dst) { unsigned keep;
    asm volatile("s_mov_b32 %0, m0\n\ts_mov_b32 m0, %3\n\ts_nop 0\n\tglobal_load_lds_dwordx4 %1, %2\n\ts_mov_b32 m0, %0" : "=&s"(keep) : "v"(voff), "s"(gbase), "s"(lds_dst) : "memory"); }
__device__ __forceinline__ const bf16_t* uni_ptr(const bf16_t* p) { const unsigned long long v = (unsigned long long)p; const unsigned lo = __builtin_amdgcn_readfirstlane((unsigned)v), hi = __builtin_amdgcn_readfirstlane((unsigned)(v >> 32)); return (const bf16_t*)(((unsigned long long)hi << 32) | lo); }
#define AT_WAITBAR() asm volatile("s_waitcnt vmcnt(0) lgkmcnt(0)\n\ts_barrier" ::: "memory")
#define AT_WAITBAR4() asm volatile("s_waitcnt vmcnt(4) lgkmcnt(0)\n\ts_barrier" ::: "memory")
#define AT_VFR(dst, Vb, kst) do { _Pragma("unroll") for (int eb = 0; eb < 4; ++eb) dst[eb] = cat8(tr4((Vb) + vb0 + (kst) * 4096 + eb * 512), tr4((Vb) + vb1 + (kst) * 4096 + eb * 512)); } while (0)
#define AT_PV(Vb, PF) do { _Pragma("unroll") for (int kst = 0; kst < 4; ++kst) { bf16x8 vf_[4]; AT_VFR(vf_, Vb, kst); \
        _Pragma("unroll") for (int eb = 0; eb < 4; ++eb) o[eb] = MFMA32(vf_[eb], PF[kst], o[eb]); } } while (0)
#define AT_QK(S0, S1, Kb) do { if constexpr (SAFE) { S0 = MFMA32(*(const LAS bf16x8*)((Kb) + kofs[0]), qf[0], zero16); S1 = MFMA32(*(const LAS bf16x8*)((Kb) + kofs[0] + 4096), qf[0], zero16); } \
        else { S0 = MFMA32(*(const LAS bf16x8*)((Kb) + kofs[0]), qf[0], negm); S1 = MFMA32(*(const LAS bf16x8*)((Kb) + kofs[0] + 4096), qf[0], negm); } \
        _Pragma("unroll") for (int ks = 1; ks < 4; ++ks) { S0 = MFMA32(*(const LAS bf16x8*)((Kb) + kofs[ks]), qf[ks], S0); S1 = MFMA32(*(const LAS bf16x8*)((Kb) + kofs[ks] + 4096), qf[ks], S1); } } while (0)
constexpr int AT_CV = 98304, CV_TOTAL = 65536 + 32768;
__device__ __forceinline__ void cv_decode(const Frame& F, int idx, const float*& src, int& ldw, unsigned char*& dst) {
    if (idx < 65536) { const int k16 = idx & 63, grp = (idx >> 6) & 31, e = idx >> 11, nt = grp >> 2, bj = (grp >> 1) & 1, hf = grp & 1, ca = bj * 1024 + nt * 128 + 64 * hf;
        src = F.in[I_WGU] + (size_t)e * 1024 * 2048 + (size_t)(16 * k16) * 2048 + ca; ldw = 2048; dst = F.ws + WS_WGU + ((size_t)e * 2048 + 64 * grp) * 1024 + 16 * k16; }
    else { const int r = idx - 65536, k16 = r & 63, g = (r >> 6) & 15, e = r >> 10;
        src = F.in[I_WD] + (size_t)e * 1024 * 1024 + (size_t)(16 * k16) * 1024 + 64 * g; ldw = 1024; dst = F.ws + WS_WD + ((size_t)e * 1024 + 64 * g) * 1024 + 16 * k16; }
}
__device__ __forceinline__ void cv_issue(const Frame& F, int idx, unsigned lds_dst, int lane) {
    const float* src; int ldw; unsigned char* dst; cv_decode(F, idx, src, ldw, dst);
    const bf16_t* g = uni_ptr((const bf16_t*)src);
#pragma unroll
    for (int j = 0; j < 4; ++j) at_dma(g, (unsigned)(((4 * j + (lane >> 4)) * ldw + 4 * (lane & 15)) * 4), lds_dst + j * 1024);
}
__device__ __forceinline__ void cv_convert(const Frame& F, int idx, const LAS float* scr, int lane) {
    const float* src; int ldw; unsigned char* dst; cv_decode(F, idx, src, ldw, dst);
    float v[16];
#pragma unroll
    for (int i = 0; i < 16; ++i) v[i] = scr[i * 64 + lane] * WSCALE;
    u32x4 o; o.x = pk4_fp8(v[0], v[1], v[2], v[3]); o.y = pk4_fp8(v[4], v[5], v[6], v[7]); o.z = pk4_fp8(v[8], v[9], v[10], v[11]); o.w = pk4_fp8(v[12], v[13], v[14], v[15]);
    *(u32x4*)(dst + (size_t)lane * 1024) = o;
}
#define AT_CVSTEP() do { if (cv_cur >= 0) { cv_convert(F, cv_cur, (const LAS float*)(L + AT_CV + w * 4096), lane); cv_cur = -1; } \
    if (cv_idx < cv_end && ((++cv_tick) & 7) == 0) { cv_issue(F, cv_idx, lds0 + AT_CV + w * 4096, lane); cv_cur = cv_idx; ++cv_idx; } } while (0)
#define AT_HEAD(i) do { AT_CVSTEP(); \
    if ((i) + 3 < NT) { const bf16_t* gk_ = uni_ptr(DKu + (size_t)((i) + 3) * 64 * 512); at_dma(gk_, kvo[0], lds0 + AT_K0 + k0 + w * 1024); at_dma(gk_, kvo[1], lds0 + AT_K0 + k0 + 8192 + w * 1024); } \
    if ((i) + 1 < NT) { const bf16_t* gv_ = uni_ptr(DVu + (size_t)((i) + 1) * 64 * 512); at_dma(gv_, vvo[0], lds0 + AT_V0 + vnext + w * 1024); at_dma(gv_, vvo[1], lds0 + AT_V0 + vnext + 8192 + w * 1024); } } while (0)
#define AT_HEAD_FAR(i) do { AT_CVSTEP(); \
    { const bf16_t* gk_ = uni_ptr(DKu + (size_t)((i) + 3) * 64 * 512); at_dma(gk_, kvo[0], lds0 + AT_K0 + k0 + w * 1024); at_dma(gk_, kvo[1], lds0 + AT_K0 + k0 + 8192 + w * 1024); } \
    { const bf16_t* gv_ = uni_ptr(DVu + (size_t)((i) + 1) * 64 * 512); at_dma(gv_, vvo[0], lds0 + AT_V0 + vnext + w * 1024); at_dma(gv_, vvo[1], lds0 + AT_V0 + vnext + 8192 + w * 1024); } } while (0)
#define AT_BANDFIX(i, S0, S1) do { const int d0_ = qpos - 64 * (i);                  \
            float b0_[16], b1_[16]; \
            _Pragma("unroll") for (int r_ = 0; r_ < 16; ++r_) { const int dd_ = d0_ - crow(r_, hh), d2_ = dd_ - 32; b0_[r_] = BT[min(max(dd_, 0), 127)]; b1_[r_] = BT[min(max(d2_, 0), 127)]; } \
            _Pragma("unroll") for (int r_ = 0; r_ < 16; ++r_) { const int dd_ = d0_ - crow(r_, hh), d2_ = dd_ - 32; S0[r_] = dd_ < 0 ? -1e30f : S0[r_] + b0_[r_]; S1[r_] = d2_ < 0 ? -1e30f : S1[r_] + b1_[r_]; } } while (0)
#define AT_CORE(i, S0, S1, PF) do { \
        if constexpr (!SAFE) { \
        float mx_ = max3f(S0[0], S1[0], S0[1]); mx_ = max3f(mx_, S1[1], S0[2]); \
        _Pragma("unroll") for (int r_ = 3; r_ < 15; r_ += 2) { mx_ = max3f(mx_, S0[r_], S1[r_ - 1]); mx_ = max3f(mx_, S0[r_ + 1], S1[r_]); } \
        mx_ = max3f(mx_, S0[15], S1[14]); mx_ = xmax32(fmaxf(mx_, S1[15])); \
        if (__any(mx_ > AT_THR)) {                                                   \
            { const LAS unsigned char* Vp_ = L + AT_V0 + vprev; AT_PV(Vp_, PF); } \
            _Pragma("unroll") for (int k_ = 0; k_ < 4; ++k_) PF[k_] = (bf16x8){0, 0, 0, 0, 0, 0, 0, 0}; \
            const float dl_ = fmaxf(mx_, 0.f), al_ = fast_exp2(-dl_); lrun *= al_; mref += dl_; \
            _Pragma("unroll") for (int r_ = 0; r_ < 16; ++r_) { negm[r_] = -mref; S0[r_] -= dl_; S1[r_] -= dl_; } \
            _Pragma("unroll") for (int eb = 0; eb < 4; ++eb) _Pragma("unroll") for (int r_ = 0; r_ < 16; ++r_) o[eb][r_] *= al_; } \
        } \
        { const LAS unsigned char* Vp_ = L + AT_V0 + vprev; AT_PV(Vp_, PF); } \
        float pa_ = 0.f, pb_ = 0.f; \
        _Pragma("unroll") for (int r_ = 0; r_ < 16; ++r_) { S0[r_] = fast_exp2(S0[r_]); S1[r_] = fast_exp2(S1[r_]); pa_ += S0[r_]; pb_ += S1[r_]; } \
        lrun += pa_ + pb_; \
        PF[0] = pack_step(S0, 0); PF[1] = pack_step(S0, 1); PF[2] = pack_step(S1, 0); PF[3] = pack_step(S1, 1); \
        { const LAS unsigned char* Kb_ = L + AT_K0 + k1; AT_QK(S0, S1, Kb_); } } while (0)
#define SBAR() __builtin_amdgcn_sched_barrier(0)
#define PINV(x) asm volatile("" : "+v"(x))
#define AT_VRD(n) do { vl[n] = tr4(va0_ + ((n) >> 2) * 4096 + ((n) & 3) * 512); vh[n] = tr4(va1_ + ((n) >> 2) * 4096 + ((n) & 3) * 512); } while (0)
#define AT_VF(n) cat8(vl[n], vh[n])
#define AT_PVM(n) o[(n) & 3] = MFMA32(AT_VF(n), __builtin_bit_cast(bf16x8, pw[(n) >> 2]), o[(n) & 3])
#define AT_GX(n, X, j) do { AT_VRD((n) + 2); SBAR(); AT_PVM(n); \
    X[j] = fast_exp2(X[j]); X[(j) + 1] = fast_exp2(X[(j) + 1]); X[(j) + 2] = fast_exp2(X[(j) + 2]); X[(j) + 3] = fast_exp2(X[(j) + 3]); PINV(X); SBAR(); } while (0)
#define AT_KRD(m) kf[m] = *(const LAS bf16x8*)(ka_[(m) >> 1] + ((m) & 1) * 4096)
#define AT_GS(n, X, j, k, e, RD) do { RD; AT_KRD((n) - 8); SBAR(); AT_PVM(n); \
    sa_ += X[j]; sb_ += X[(j) + 1]; sa_ += X[(j) + 2]; sb_ += X[(j) + 3]; pw[k][e] = cvtpk(X[j], X[(j) + 1]); pw[k][(e) + 1] = cvtpk(X[(j) + 2], X[(j) + 3]); PINV(pw[k]); PINV(sa_); PINV(sb_); SBAR(); } while (0)
#define AT_GA(n, X, j) do { AT_KRD((n) - 8); SBAR(); AT_PVM(n); sa_ += X[j]; sb_ += X[(j) + 1]; sa_ += X[(j) + 2]; sb_ += X[(j) + 3]; PINV(sa_); PINV(sb_); SBAR(); } while (0)
#define AT_CORE_H(i, S0, S1, D0, D1, D2, D3) do { \
    const LAS unsigned char* va0_ = L + AT_V0 + vprev + vb0; const LAS unsigned char* va1_ = L + AT_V0 + vprev + vb1; \
    const LAS unsigned char* ka_[4]; _Pragma("unroll") for (int ks = 0; ks < 4; ++ks) ka_[ks] = L + AT_K0 + k1 + kofs[ks]; \
    float sa_ = 0.f, sb_ = 0.f; bf16x8 kf[8]; SBAR(); \
    S0[0] = fast_exp2(S0[0]); S0[1] = fast_exp2(S0[1]); S0[2] = fast_exp2(S0[2]); S0[3] = fast_exp2(S0[3]); PINV(S0); SBAR();        \
    AT_GX(0, S0, 4); AT_GX(1, S0, 8); AT_GX(2, S0, 12); AT_GX(3, S1, 0); AT_GX(4, S1, 4); AT_GX(5, S1, 8); AT_GX(6, S1, 12); AT_VRD(9); SBAR(); AT_PVM(7); SBAR(); \
    AT_GS(8, S0, 0, 0, 0, AT_VRD(10)); AT_GS(9, S0, 4, 0, 2, AT_VRD(11)); AT_GS(10, S0, 8, 1, 0, AT_VRD(12)); AT_GS(11, S0, 12, 1, 2, AT_VRD(13)); \
    AT_GS(12, S1, 0, 2, 0, AT_VRD(14)); AT_GS(13, S1, 4, 2, 2, AT_VRD(15)); AT_GA(14, S1, 8); AT_GA(15, S1, 12); \
    S0 = MFMA32(kf[0], qf[0], zero16); pw[3][0] = cvtpk(S1[8], S1[9]); pw[3][1] = cvtpk(S1[10], S1[11]); pw[3][2] = cvtpk(S1[12], S1[13]); pw[3][3] = cvtpk(S1[14], S1[15]); PINV(pw[3]); SBAR(); \
    S1 = MFMA32(kf[1], qf[0], zero16); lrun += sa_ + sb_; PINV(lrun); SBAR(); \
    S0 = MFMA32(kf[2], qf[1], S0); SBAR(); D0; SBAR(); S1 = MFMA32(kf[3], qf[1], S1); SBAR(); D1; SBAR(); S0 = MFMA32(kf[4], qf[2], S0); SBAR(); D2; SBAR(); S1 = MFMA32(kf[5], qf[2], S1); SBAR(); D3; SBAR(); \
    S0 = MFMA32(kf[6], qf[3], S0); SBAR(); S1 = MFMA32(kf[7], qf[3], S1); SBAR(); } while (0)
#define AT_FD0(i) const bf16_t* gk_ = uni_ptr(DKu + (size_t)((i) + 3) * 64 * 512); at_dma(gk_, kvo[0], lds0 + AT_K0 + k0 + w * 1024)
#define AT_FD1(i) at_dma(gk_, kvo[1], lds0 + AT_K0 + k0 + 8192 + w * 1024)
#define AT_FD2(i) const bf16_t* gv_ = uni_ptr(DVu + (size_t)((i) + 1) * 64 * 512); at_dma(gv_, vvo[0], lds0 + AT_V0 + vnext + w * 1024)
#define AT_FD3(i) at_dma(gv_, vvo[1], lds0 + AT_V0 + vnext + 8192 + w * 1024)
#define AT_VPRE() do { const LAS unsigned char* va0_ = L + AT_V0 + vprev + vb0; const LAS unsigned char* va1_ = L + AT_V0 + vprev + vb1; AT_VRD(0); AT_VRD(1); SBAR(); } while (0)
#define AT_PV_H() do { const LAS unsigned char* va0_ = L + AT_V0 + vprev + vb0; const LAS unsigned char* va1_ = L + AT_V0 + vprev + vb1; SBAR(); \
    AT_VRD(2); SBAR(); AT_PVM(0); SBAR(); AT_VRD(3); SBAR(); AT_PVM(1); SBAR(); AT_VRD(4); SBAR(); AT_PVM(2); SBAR(); AT_VRD(5); SBAR(); AT_PVM(3); SBAR(); AT_VRD(6); SBAR(); AT_PVM(4); SBAR(); AT_VRD(7); SBAR(); AT_PVM(5); SBAR(); \
    AT_VRD(8); SBAR(); AT_PVM(6); SBAR(); AT_VRD(9); SBAR(); AT_PVM(7); SBAR(); AT_VRD(10); SBAR(); AT_PVM(8); SBAR(); AT_VRD(11); SBAR(); AT_PVM(9); SBAR(); AT_VRD(12); SBAR(); AT_PVM(10); SBAR(); AT_VRD(13); SBAR(); AT_PVM(11); SBAR(); \
    AT_VRD(14); SBAR(); AT_PVM(12); SBAR(); AT_VRD(15); SBAR(); AT_PVM(13); SBAR(); AT_PVM(14); SBAR(); AT_PVM(15); SBAR(); } while (0)
#define AT_ROT() do { vprev = vcur; vcur = vnext; vnext = (vnext == 2 * AT_VB) ? 0 : vnext + AT_VB; { const int t_ = k0; k0 = k1; k1 = k2; k2 = t_; } } while (0)
#define AT_TAIL() do { AT_ROT(); AT_WAITBAR(); } while (0)
#define AT_TAIL4() do { AT_ROT(); AT_WAITBAR4(); } while (0)

template <bool SAFE>
__device__ __forceinline__ void attn_body(Frame& F) {
    LAS unsigned char* L = F.lds; const unsigned lds0 = (unsigned)(uintptr_t)F.lds;
    const bf16_t* DQ = (const bf16_t*)(F.ws + WS_DQ); const bf16_t* DK = (const bf16_t*)(F.ws + WS_DK); const bf16_t* DV = (const bf16_t*)(F.ws + WS_DV); bf16_t* Y = (bf16_t*)(F.ws + WS_XN);
    const int w = F.wave, c = w >> 2, jw = w & 3;
    const int cv_per = (CV_TOTAL + F.G * 8 - 1) / (F.G * 8); int cv_idx = (F.vcu * 8 + w) * cv_per, cv_cur = -1, cv_tick = 0; const int cv_end = min(CV_TOTAL, cv_idx + cv_per);
    LAS float* BT = (LAS float*)(L + AT_BIAS); LAS float* LAMP = (LAS float*)(L + AT_LAM);
    if (w == 0) { const int l0 = lane_id(); const float a = F.in[I_LQ1][l0] * F.in[I_LK1][l0], b = F.in[I_LQ2][l0] * F.in[I_LK2][l0];
        const float sa = wave_sum(a), sb = wave_sum(b); if (l0 == 0) LAMP[0] = __expf(sa) - __expf(sb) + 0.2f; }
    const float* relb = F.in[I_RELB]; LAS float* SUBG = (LAS float*)(L + AT_LAM + 64);
    { const int n = w * 64 + lane_id(); if (n < 128) SUBG[n] = F.in[I_SUBG][n]; }
#if defined(PROBE_AT)
    unsigned long long pa_far = 0, pa_nfar = 0, pa_seg[6] = {0, 0, 0, 0, 0, 0}, pa_min5 = ~0ull, pa_minb = ~0ull, pa_faru = 0; const unsigned long long pa_t0 = clock64();
#define PA_T(k) const unsigned long long pt##k = clock64()
#else
#define PA_T(k)
#endif
    for (int vv = F.vcu; vv < 256; vv += F.G) {
        const int bh = vv >> 3, sidx = vv & 7, h = bh & 3, b = bh >> 2; const size_t rowbase = (size_t)b * SEQ;
        __syncthreads();
        { const int n = w * 64 + lane_id(); if (n < 128) { int bucket = n;
            if (n >= 16) { bucket = 16 + (int)(__logf((float)n * (1.f / 16.f)) / __logf(8.f) * 16.f); if (bucket > 31) bucket = 31; }
            BT[n] = (relb[bucket * 4 + h] - relb[31 * 4 + h]) * LOG2E; } }
        bf16x8 qn[4];
#define AT_QLOAD(UI) do { const int pr_ = (UI) >> 1, qb_ = ((UI) & 1) ? (63 - 8 * pr_ - sidx) : (8 * pr_ + sidx); const int l_ = lane_id(); \
        const size_t qrow_ = rowbase + (size_t)(qb_ * 128 + 32 * (w & 3) + (l_ & 31)); \
        _Pragma("unroll") for (int ks = 0; ks < 4; ++ks) qn[ks] = *(const bf16x8*)(DQ + qrow_ * 512 + h * 128 + (w >> 2) * 64 + 16 * ks + 8 * (l_ >> 5)); } while (0)
        AT_QLOAD(0);
        for (int ui = 0; ui < 8; ++ui) {
            const int pr = ui >> 1, qb = (ui & 1) ? (63 - 8 * pr - sidx) : (8 * pr + sidx);
            PA_T(0);
            const int lane = lane_id(), hh = lane >> 5, ql = lane & 31, blk = (lane >> 4) & 1, q4 = (lane & 15) >> 2, p4 = lane & 3;
            const int vb0 = 64 * (4 * hh + q4) + 16 * ((2 * blk + (p4 >> 1)) ^ hh) + 8 * (p4 & 1), vb1 = 2048 + 64 * (4 * hh + q4) + 16 * ((2 * blk + (p4 >> 1)) ^ ((2 + hh) & 3)) + 8 * (p4 & 1);
            int kofs[4];
#pragma unroll
            for (int ks = 0; ks < 4; ++ks) kofs[ks] = c * 8192 + ql * 128 + 16 * ((2 * ks + hh) ^ ((ql >> 1) & 7));
            unsigned kvo[2], vvo[2];
#pragma unroll
            for (int p = 0; p < 2; ++p) { const int r = 8 * w + (lane >> 3), ch = (lane & 7) ^ ((r >> 1) & 7); kvo[p] = (unsigned)(r * 1024 + (h * 128 + p * 64 + 8 * ch) * 2);
                const int j = w + 8 * p, row = 8 * (j >> 1) + ((lane >> 2) & 7), chv = 4 * (2 * (j & 1) + (lane >> 5)) + ((lane & 3) ^ ((row >> 2) & 3)); vvo[p] = (unsigned)(row * 1024 + (h * 128 + 8 * chv) * 2); }
            const int q0 = qb * 128, NT = (q0 + 128) >> 6, qw0 = q0 + 32 * jw, qpos = qw0 + ql;
            const int NA = min(NT, ((qw0 + 31) >> 6) + 1);
            const bf16_t* DKu = DK + rowbase * 512; const bf16_t* DVu = DV + rowbase * 512;
            bf16x8 qf[4];
#pragma unroll
            for (int ks = 0; ks < 4; ++ks) qf[ks] = qn[ks];
#define AT_PROLOGUE_DMA() do { const bf16_t* g0 = uni_ptr(DKu); const bf16_t* g1 = uni_ptr(DKu + 64 * 512); const bf16_t* g2 = uni_ptr(DKu + 128 * 512); const bf16_t* gv = uni_ptr(DVu); \
                at_dma(g0, kvo[0], lds0 + AT_K0 + w * 1024); at_dma(g0, kvo[1], lds0 + AT_K0 + 8192 + w * 1024); \
                at_dma(g1, kvo[0], lds0 + AT_K0 + AT_KB + w * 1024); at_dma(g1, kvo[1], lds0 + AT_K0 + AT_KB + 8192 + w * 1024); \
                at_dma(g2, kvo[0], lds0 + AT_K0 + 2 * AT_KB + w * 1024); at_dma(g2, kvo[1], lds0 + AT_K0 + 2 * AT_KB + 8192 + w * 1024);          \
                at_dma(gv, vvo[0], lds0 + AT_V0 + w * 1024); at_dma(gv, vvo[1], lds0 + AT_V0 + 8192 + w * 1024); } while (0)
            if (ui == 0) { __syncthreads(); AT_PROLOGUE_DMA(); }
            f32x16 o[4];
#pragma unroll
            for (int eb = 0; eb < 4; ++eb) for (int i = 0; i < 16; ++i) o[eb][i] = 0.f;
            const f32x16 zero16 = {0.f, 0.f, 0.f, 0.f, 0.f, 0.f, 0.f, 0.f, 0.f, 0.f, 0.f, 0.f, 0.f, 0.f, 0.f, 0.f}; (void)zero16;
            float mref = 0.f, lrun = 0.f;
            f32x16 negm;
#pragma unroll
            for (int i = 0; i < 16; ++i) negm[i] = 0.f;
            bf16x8 pf[4];
#pragma unroll
            for (int k = 0; k < 4; ++k) pf[k] = (bf16x8){0, 0, 0, 0, 0, 0, 0, 0};
            int vprev = 0, vcur = 0, vnext = AT_VB, k0 = 0, k1 = AT_KB, k2 = 2 * AT_KB;
            AT_WAITBAR();
            PA_T(1);
            if (c == 1) __builtin_amdgcn_s_setprio(1);
            f32x16 s0, s1;
            { const LAS unsigned char* Kb = L + AT_K0; AT_QK(s0, s1, Kb); }
            u32x4 pw[4]; s16x4 vl[16], vh[16];
#pragma unroll
            for (int k = 0; k < 4; ++k) pw[k] = (u32x4){0u, 0u, 0u, 0u};
            asm volatile("s_waitcnt lgkmcnt(0)\n\ts_barrier" ::: "memory");
            PA_T(2);
            const int nfar = max(0, (qw0 - 112) >> 6);
            int i = 0;
            if constexpr (SAFE) {
#if defined(PROBE_AT)
                const unsigned long long pc0_ = clock64();
#endif
                for (; i < nfar; ++i) { AT_VPRE(); AT_CVSTEP(); AT_CORE_H(i, s0, s1, AT_FD0(i), AT_FD1(i), AT_FD2(i), AT_FD3(i)); AT_TAIL4(); }
#if defined(PROBE_AT)
                pa_faru = clock64() - pc0_; pa_far += pa_faru; pa_nfar += nfar;
#endif
                for (; i < NA; ++i) { AT_VPRE(); AT_HEAD(i); AT_BANDFIX(i, s0, s1); AT_CORE_H(i, s0, s1, , , , ); AT_TAIL(); }
                AT_VPRE(); AT_PV_H();
            } else {
                for (; i < nfar; ++i) { AT_HEAD_FAR(i); AT_CORE(i, s0, s1, pf); AT_TAIL4(); }
                for (; i < NA; ++i) { AT_HEAD(i); AT_BANDFIX(i, s0, s1); AT_CORE(i, s0, s1, pf); AT_TAIL(); }
                { const LAS unsigned char* Vp = L + AT_V0 + vprev; AT_PV(Vp, pf); }
            }
            PA_T(3);
            for (; i < NT; ++i) { AT_HEAD(i); AT_TAIL(); }
            PA_T(4);
            __builtin_amdgcn_s_setprio(0);
            if (cv_cur >= 0) { cv_convert(F, cv_cur, (const LAS float*)(L + AT_CV + w * 4096), lane); cv_cur = -1; }
            AT_WAITBAR();
            PA_T(5);
            if (ui < 7) { AT_PROLOGUE_DMA(); AT_QLOAD(ui + 1); }
            const float ltot = xsum32(lrun); const float inv = fast_rcp(ltot);
            const int lane2 = lane_id();
            const int ql2 = lane2 & 31, hh2 = lane2 >> 5;
            LAS float* X = (LAS float*)(L + AT_XCH) + jw * 4096;
            if (c == 1) { const float sc = inv * LAMP[0];
#pragma unroll
                for (int eb = 0; eb < 4; ++eb) for (int i = 0; i < 16; ++i) X[(eb * 16 + i) * 64 + lane2] = o[eb][i] * sc; }
            __syncthreads();
            if (c == 0) { float ss = 0.f;
#pragma unroll
                for (int eb = 0; eb < 4; ++eb) for (int i = 0; i < 16; ++i) { const float v = o[eb][i] * inv - X[(eb * 16 + i) * 64 + lane2]; o[eb][i] = v; ss += v * v; }
                ss = xsum32(ss);
                const float rs = __builtin_amdgcn_rsqf(ss * (1.f / 128.f) + EPS) * 0.8f;
                LDS_WAIT();
                LAS unsigned char* OS = (LAS unsigned char*)X;
#pragma unroll
                for (int eb = 0; eb < 4; ++eb)
#pragma unroll
                    for (int g4 = 0; g4 < 4; ++g4) { const int e = 32 * eb + 8 * g4 + 4 * hh2; const f32x4 gg = *(const LAS f32x4*)(SUBG + e);
                        u32x2 wv; wv.x = cvtpk(o[eb][4 * g4] * rs * gg[0], o[eb][4 * g4 + 1] * rs * gg[1]); wv.y = cvtpk(o[eb][4 * g4 + 2] * rs * gg[2], o[eb][4 * g4 + 3] * rs * gg[3]);
                        *(LAS u32x2*)(OS + ql2 * AT_OSTR + e * 2) = wv; }
                LDS_WAIT();
#pragma unroll
                for (int p = 0; p < 8; ++p) { const int idx = lane2 + 64 * p, r = idx >> 4, ch = idx & 15;
                    *(u32x4*)(Y + (rowbase + qw0 + r) * DM + 512 + h * 128 + 8 * ch) = *(const LAS u32x4*)(OS + r * AT_OSTR + 16 * ch); }
            }
#if defined(PROBE_AT)
            { const unsigned long long pt6 = clock64(); pa_seg[0] += pt1 - pt0; pa_seg[1] += pt2 - pt1; pa_seg[2] += pt3 - pt2; pa_seg[3] += pt4 - pt3; pa_seg[4] += pt5 - pt4; pa_seg[5] += pt6 - pt5; pa_min5 = min(pa_min5, pt6 - pt5); pa_minb = min(pa_minb, pt3 - pt2 - pa_faru); }
#endif
        }
    }
#if defined(PROBE_AT)
    if (F.vcu == 0 && w == 0 && lane_id() == 0) { const unsigned long long tot = clock64() - pa_t0; float v;
        if (PROBE_AT == 1) v = rintf((float)pa_far / (float)pa_nfar * 0.002f) * 500.f;
        else if (PROBE_AT == 2) v = rintf((float)pa_far / (float)tot * 50.f) * 20.f;
        else if (PROBE_AT == 3) v = rintf((float)tot * 1e-4f) * 10.f;
        else if (PROBE_AT == 16) v = rintf((float)(pa_seg[2] - pa_far) * (1.f / 8.f) * 0.002f) * 500.f;
        else if (PROBE_AT == 36) v = rintf((float)(pa_seg[2] - pa_far) * (1.f / 8.f) * 0.001f) * 1000.f;
        else if (PROBE_AT == 45) v = rintf((float)pa_seg[5] * (1.f / 8.f) * 0.001f) * 1000.f;
        else if (PROBE_AT == 46) v = rintf((float)pa_min5 * 0.002f) * 500.f;
        else if (PROBE_AT == 37) v = rintf((float)pa_minb * 0.002f) * 500.f;
        else if (PROBE_AT == 25) v = rintf((float)pa_seg[5] * (1.f / 8.f) * (1.f / 700.f)) * 700.f;
        else v = rintf((float)pa_seg[PROBE_AT - 10] * (1.f / 8.f) * 0.002f) * 500.f;
        ((float*)(F.ws + WS_WRF + 1048576))[0] = v; }
#endif
    __syncthreads();
    { const int lane = lane_id();
        for (;;) { if (cv_cur >= 0) { asm volatile("s_waitcnt vmcnt(0)" ::: "memory"); cv_convert(F, cv_cur, (const LAS float*)(L + AT_CV + w * 4096), lane); cv_cur = -1; }
            if (cv_idx >= cv_end) break;
            cv_issue(F, cv_idx, lds0 + AT_CV + w * 4096, lane); cv_cur = cv_idx; ++cv_idx; } }
}

__device__ __forceinline__ void attn_phase(Frame& F) {
    LAS float* FL = (LAS float*)(F.lds + AT_LAM);
    __syncthreads();
    if (F.wave == 0) { const int l0 = lane_id(); const float gq = fabsf(F.in[I_QG][l0]), gk = fabsf(F.in[I_KG][l0]);
        float mq = gq, mk = gk, bhi = 0.f, blo = 0.f;
#pragma unroll
        for (int o = 1; o < 64; o <<= 1) { mq = fmaxf(mq, __shfl_xor(mq, o)); mk = fmaxf(mk, __shfl_xor(mk, o)); }
        const float* relb = F.in[I_RELB];
        for (int i = 0; i < 128; ++i) { const float d = relb[i] - relb[124 + (i & 3)]; bhi = fmaxf(bhi, d); blo = fminf(blo, d); }
        const float qk = 8.f * mq * mk; const bool safe = (qk + bhi) * LOG2E < 60.f && (-qk + blo) * LOG2E > -60.f && qk == qk;
        if (l0 == 0) FL[1] = safe ? 1.f : 0.f; }
    __syncthreads();
    const bool safe = FL[1] != 0.f;
    if (safe) attn_body<true>(F); else attn_body<false>(F);
}
#undef AT_PV
#undef AT_VFR
#undef AT_QK
#undef AT_HEAD
#undef AT_HEAD_FAR
#undef AT_BANDFIX
#undef AT_CORE
#undef AT_TAIL
#undef AT_TAIL4
#undef AT_QLOAD
#undef AT_PROLOGUE_DMA
#undef AT_ROT
#undef AT_VPRE
#undef AT_WAITBAR4
#undef AT_CORE_H
#undef AT_PV_H
#undef AT_GX
#undef AT_GS
#undef AT_GA
#undef AT_KRD
#undef AT_PVM
#undef AT_VF
#undef AT_VRD
#undef AT_CVSTEP
#undef AT_WAITBAR
constexpr int RT_TSTR = 272;
constexpr int RT_TILE = 0, RT_LOG = 8 * 32 * RT_TSTR, RT_RS = RT_LOG + 8 * 32 * 33 * 4, RT_CNT = RT_RS + 8 * 32 * 4, RT_BASE = RT_CNT + 128;
template <bool REAL>
__device__ __forceinline__ void route_phase(Frame& F) {
    LAS unsigned char* L = F.lds;
    const float* H = F.out; unsigned char* M2 = F.ws + WS_XN; const float* gn = F.in[I_N2G]; const float* br = F.in[I_BR];
    const bf16_t* wrf = (const bf16_t*)(F.ws + WS_WRF); int* ldst = (int*)(F.ws + WS_LDST); float* lgate = (float*)(F.ws + WS_LGATE); float* lrs = (float*)(F.ws + WS_LRS);
    const int tid = (F.wave * 64 + lane_id()), lane = lane_id(), w = F.wave, hh = lane >> 5, l31 = lane & 31;
    LAS unsigned char* TL = L + RT_TILE + w * 32 * RT_TSTR; LAS float* LG = (LAS float*)(L + RT_LOG) + w * 32 * 33; LAS float* RS = (LAS float*)(L + RT_RS) + w * 32;
    LAS int* CNT = (LAS int*)(L + RT_CNT); LAS int* BASE = (LAS int*)(L + RT_BASE);
    for (int bt = F.vcu; bt < T / 256; bt += F.G) {
        const size_t row0 = (size_t)bt * 256 + 32 * w;
        if (tid < 32) CNT[tid] = 0;
        f32x16 acc; for (int i = 0; i < 16; ++i) acc[i] = 0.f;
        float ss[16];
#pragma unroll
        for (int i = 0; i < 16; ++i) ss[i] = 0.f;
        for (int ch = 0; ch < 8; ++ch) { const int col = 128 * ch + 4 * l31; const f32x4 g = *(const f32x4*)(gn + col);
            f32x4 hv[16];
#pragma unroll
            for (int i = 0; i < 16; ++i) hv[i] = *(const f32x4*)(H + (row0 + 2 * i + hh) * DM + col);
#pragma unroll
            for (int i = 0; i < 16; ++i) { const int r = 2 * i + hh; ss[i] += (hv[i].x * hv[i].x + hv[i].y * hv[i].y) + (hv[i].z * hv[i].z + hv[i].w * hv[i].w); const f32x4 v = hv[i] * g;
                u32x2 wv; wv.x = cvtpk(v.x, v.y); wv.y = cvtpk(v.z, v.w);
                *(unsigned*)(M2 + (row0 + r) * DM + col) = pk4_fp8(v.x, v.y, v.z, v.w); *(LAS u32x2*)(TL + r * RT_TSTR + 8 * l31) = wv; }
            LDS_WAIT();
#pragma unroll
            for (int ks = 0; ks < 8; ++ks) { const bf16x8 a = *(const LAS bf16x8*)(TL + l31 * RT_TSTR + (16 * ks + 8 * hh) * 2); const bf16x8 bfr = *(const bf16x8*)(wrf + ((size_t)(8 * ch + ks) * 64 + lane) * 8);
                acc = MFMA32(a, bfr, acc); }
            LDS_WAIT();
        }
#pragma unroll
        for (int i = 0; i < 16; ++i) { float s = ss[i];
#pragma unroll
            for (int o = 1; o < 32; o <<= 1) s += __shfl_xor(s, o);
            if (l31 == 0) RS[2 * i + hh] = __builtin_amdgcn_rsqf(s * (1.f / DM) + EPS); }
#pragma unroll
        for (int i = 0; i < 16; ++i) LG[crow(i, hh) * 33 + l31] = acc[i];
        LDS_WAIT();
        __syncthreads();
        int ek[4] = {0, 0, 0, 0}; float gk[4] = {0.f, 0.f, 0.f, 0.f}; int pk[4] = {0, 0, 0, 0};
        if (lane < 32) { float v[32];
            const float rsl = RS[lane];
#pragma unroll
            for (int e = 0; e < 32; ++e) v[e] = LG[lane * 33 + e] * rsl + br[e];
            unsigned taken = 0u; float tv[4];
#pragma unroll
            for (int k = 0; k < 4; ++k) { float best = -3.0e38f; int bi = 0;
#pragma unroll
                for (int e = 0; e < 32; ++e) { const bool ok = !((taken >> e) & 1u) && v[e] > best; best = ok ? v[e] : best; bi = ok ? e : bi; }
                taken |= 1u << bi; ek[k] = bi; tv[k] = best; }
            const float e1 = __expf(tv[1] - tv[0]), e2 = __expf(tv[2] - tv[0]), e3 = __expf(tv[3] - tv[0]); const float inv = 1.f / (1.f + e1 + e2 + e3);
            gk[0] = inv; gk[1] = e1 * inv; gk[2] = e2 * inv; gk[3] = e3 * inv;
#pragma unroll
            for (int k = 0; k < 4; ++k) pk[k] = __hip_atomic_fetch_add(CNT + ek[k], 1, __ATOMIC_RELAXED, __HIP_MEMORY_SCOPE_WORKGROUP); }
        __syncthreads();
        if (tid < 32) BASE[tid] = REAL ? (int)__hip_atomic_fetch_add(F.ctl + CW_CNT + 64 * tid, (unsigned)CNT[tid], RLX_AGENT) : 0;
        __syncthreads();
        if (lane < 32 && REAL) { const int tok = (int)row0 + lane;
#pragma unroll
            for (int k = 0; k < 4; ++k) { const int p = BASE[ek[k]] + pk[k]; ldst[ek[k] * 65536 + p] = tok * 4 + k; lgate[ek[k] * 65536 + p] = gk[k]; lrs[ek[k] * 65536 + p] = RS[lane]; } }
        __syncthreads();
    }
}

template <bool REAL>
__device__ __forceinline__ void combine_phase(Frame& F) {
    const int gw = F.vcu * 8 + F.wave, NGW = F.G * 8;
    const unsigned char* Y0 = F.ws + WS_YS0; const unsigned char* Y1 = F.ws + WS_YS1; const unsigned char* Y2 = F.ws + WS_YS2; const unsigned char* Y3 = F.ws + WS_YS3;
    for (int m0 = gw; m0 < T; m0 += 2 * NGW) {
        f32x4 o[2][4]; unsigned x[2][4], y[2][4], z[2][4], q[2][4];
#pragma unroll
        for (int r = 0; r < 2; ++r) { const int m = m0 + r * NGW; if (m < T) { const f32x4* op = (const f32x4*)(F.out + (size_t)m * DM) + lane_id();
            const unsigned* a = (const unsigned*)(Y0 + (size_t)m * DM) + lane_id(); const unsigned* b = (const unsigned*)(Y1 + (size_t)m * DM) + lane_id(); const unsigned* c = (const unsigned*)(Y2 + (size_t)m * DM) + lane_id(); const unsigned* d = (const unsigned*)(Y3 + (size_t)m * DM) + lane_id();
#pragma unroll
            for (int j = 0; j < 4; ++j) { o[r][j] = op[64 * j]; x[r][j] = a[64 * j]; y[r][j] = b[64 * j]; z[r][j] = c[64 * j]; q[r][j] = d[64 * j]; } } }
#pragma unroll
        for (int r = 0; r < 2; ++r) { const int m = m0 + r * NGW; if (m < T) { f32x4* op = (f32x4*)(F.out + (size_t)m * DM) + lane_id();
#pragma unroll
            for (int j = 0; j < 4; ++j) { f32x4 v = o[r][j];
                const f32x2 xl = __builtin_amdgcn_cvt_pk_f32_fp8(x[r][j], false), xh = __builtin_amdgcn_cvt_pk_f32_fp8(x[r][j], true), yl = __builtin_amdgcn_cvt_pk_f32_fp8(y[r][j], false), yh = __builtin_amdgcn_cvt_pk_f32_fp8(y[r][j], true);
                const f32x2 zl = __builtin_amdgcn_cvt_pk_f32_fp8(z[r][j], false), zh = __builtin_amdgcn_cvt_pk_f32_fp8(z[r][j], true), ql = __builtin_amdgcn_cvt_pk_f32_fp8(q[r][j], false), qh = __builtin_amdgcn_cvt_pk_f32_fp8(q[r][j], true);
                const f32x2 sl = (xl + yl) + (zl + ql), sh = (xh + yh) + (zh + qh);
                v.x += sl.x * YSCALE_INV; v.y += sl.y * YSCALE_INV; v.z += sh.x * YSCALE_INV; v.w += sh.y * YSCALE_INV;
                if (REAL) op[64 * j] = v; else ((f32x4*)(F.ws + WS_HID + (size_t)m * DM * 4) + lane_id())[64 * j] = v; } } }
    }
}

#ifndef PROBE_DUP
#define PROBE_DUP -1
#endif
struct Args { const float* in[22]; float* out; unsigned char* ws; int ph_lo, ph_hi; };
constexpr int NPHASE = 10;
__global__ void __launch_bounds__(512, 2) hymba_fwd(Args args) {
    extern __shared__ __attribute__((aligned(16))) unsigned char lds[];
    Frame F;
    F.lds = (LAS unsigned char*)lds;
    F.wave = __builtin_amdgcn_readfirstlane((int)threadIdx.x >> 6);
    F.G = gridDim.x; { const int bx = blockIdx.x; F.vcu = (F.G % 8 == 0) ? (bx % 8) * (F.G / 8) + bx / 8 : bx; }
    F.ws = args.ws; F.out = args.out; F.ctl = (gu32*)(args.ws + WS_CTL);
#pragma unroll
    for (int i = 0; i < 22; ++i) F.in[i] = args.in[i];
    if ((F.wave * 64 + lane_id()) < 64) ((LAS unsigned*)(F.lds + LDS_CTL_OFF))[(F.wave * 64 + lane_id())] = 0u;
    __syncthreads();
    const int lo = args.ph_lo, hi = args.ph_hi;
    const bool multi = (hi - lo) > 1;
    XcdBarrier bar; bar.bar = (unsigned*)(F.ctl + CW_BAR); bar.x = 0; bar.st = nullptr; bar.wave = F.wave;
    if (multi) bar = xcd_barrier_post((unsigned*)(F.ctl + CW_BAR), (volatile LAS unsigned*)(F.lds + LDS_CTL_OFF), F.wave);
#define IN(k) (lo <= (k) && (k) < hi)
#if defined(PROBE_PH)
#define PH_STAMP(k) do { if (blockIdx.x == 0 && F.wave == 0 && lane_id() == 0) ((LAS unsigned long long*)(F.lds + LDS_CTL_OFF + 512))[k] = __builtin_amdgcn_s_memrealtime(); } while (0)
#else
#define PH_STAMP(k)
#endif
#define SEAM(k) do { if (IN(k) && IN((k) + 1)) xcd_barrier(bar); PH_STAMP((k) + 1); } while (0)
    PH_STAMP(0);
    if (IN(0)) { p0_prologue(F); if (PROBE_DUP == 0) { __syncthreads(); p0_prologue(F); } } SEAM(0);
    if (IN(1)) { pg8::DenseOrder S; S.init(F.ws + WS_XN, F.ws + WS_WIN, T, NIN, DM, F.G, (int)blockIdx.x);
        { LAS float* tb = (LAS float*)(F.lds + LDS_TAB_OFF); const int tid = F.wave * 64 + lane_id();
            if (tid < 256) tb[tid] = F.in[I_BG2][tid]; else if (tid < 320) tb[tid] = F.in[I_QG][tid - 256]; else if (tid < 384) tb[tid] = F.in[I_KG][tid - 320];
            __syncthreads(); }
        EpiInProj E{F.ws, (const LAS float*)(F.lds + LDS_TAB_OFF), (const LAS float*)(F.lds + LDS_TAB_OFF) + 256, (const LAS float*)(F.lds + LDS_TAB_OFF) + 320};
        pg8::gemm_phase<EpiInProj, pg8::DenseOrder>(F.lds, DM * 2, F.wave, S, E); if (PROBE_DUP == 1) { __syncthreads(); pg8::gemm_phase<EpiInProj, pg8::DenseOrder>(F.lds, DM * 2, F.wave, S, E); } } SEAM(1);
    if (IN(2)) { if (PROBE_DUP == 2) { gla_g01<false>(F); __syncthreads(); } gla_g01<true>(F); } SEAM(2);
    if (IN(3)) { if (PROBE_DUP == 3) { gla_scan<false>(F); __syncthreads(); } gla_scan<true>(F); } SEAM(3);
#if defined(PROBE_CLK)
    unsigned long long pc0 = 0, pt0 = 0;
    if (IN(4)) { pc0 = clock64(); pt0 = __builtin_amdgcn_s_memrealtime(); }
#endif
    if (IN(4)) { attn_phase(F); __syncthreads();
#if defined(PROBE_CLK)
        { const unsigned long long pc1 = clock64(), pt1 = __builtin_amdgcn_s_memrealtime();
          if (blockIdx.x == 0 && F.wave == 0 && lane_id() == 0) { float v;
              if (PROBE_CLK == 0) v = (float)(pc1 - pc0) / (float)(pt1 - pt0) * 10.f;
              else v = (float)(pt1 - pt0) * 0.001f;
              ((float*)(F.ws + WS_WRF + 1048576))[0] = rintf(v * 0.5f) * 2.f; } }
#endif
 if (PROBE_DUP == 4) { attn_phase(F); __syncthreads(); } gla_g3(F); if (PROBE_DUP == 41) { __syncthreads(); gla_g3(F); } } SEAM(4);
    if (IN(5)) { pg8::DenseOrder S; S.init(F.ws + WS_XN, F.ws + WS_WOUT, T, DM, DM, F.G, (int)blockIdx.x);
        EpiResid E{F.in[I_X], F.out};
        pg8::gemm_phase<EpiResid, pg8::DenseOrder>(F.lds, DM * 2, F.wave, S, E); if (PROBE_DUP == 5) { __syncthreads(); pg8::gemm_phase<EpiResid, pg8::DenseOrder>(F.lds, DM * 2, F.wave, S, E); } } SEAM(5);
    if (IN(6)) { if (PROBE_DUP == 6) { route_phase<false>(F); __syncthreads(); } route_phase<true>(F); } SEAM(6);
    if (IN(7) || IN(8)) {
        LAS int* tab = (LAS int*)(F.lds + LDS_TAB_OFF);
        __syncthreads();
        if ((F.wave * 64 + lane_id()) == 0) { int ts = 0, rp = 0;
            for (int e = 0; e < 32; ++e) { const int c = (int)__hip_atomic_load(F.ctl + CW_CNT + 64 * e, RLX_AGENT); tab[e] = ts; tab[40 + e] = rp; tab[80 + e] = c; ts += (c + 255) >> 8; rp += c; }
            tab[32] = ts; tab[72] = rp; }
        __syncthreads();
        { const int MT = tab[32];
            for (int m = F.wave * 64 + lane_id(); m < MT; m += 512) { int e = 0;
#pragma unroll 1
                for (int s2 = 16; s2 >= 1; s2 >>= 1) if (tab[e + s2] <= m) e += s2;
                const int mt = m - tab[e], rows = min(256, tab[80 + e] - mt * 256);
                tab[128 + 2 * m] = e | (mt << 5) | (rows << 14); tab[129 + 2 * m] = tab[40 + e] + mt * 256; } }
        __syncthreads();
    }
    if (IN(7)) { MoeOrder S{(const LAS int*)(F.lds + LDS_TAB_OFF), F.G, F.vcu, 3, 1, (const char*)(F.ws + WS_XN), (const char*)(F.ws + WS_WGU), (const int*)(F.ws + WS_LDST), (const float*)(F.ws + WS_LRS), nullptr, F.in[I_BGU]};
        EpiGateUp E{F.ws + WS_HID, (const LAS float*)(F.lds + LDS_TAB_OFF) + 2816, (const LAS float*)(F.lds + LDS_TAB_OFF) + 2304};
        pg8::gemm_phase<EpiGateUp, MoeOrder, true>(F.lds, DM, F.wave, S, E); if (PROBE_DUP == 7) { __syncthreads(); pg8::gemm_phase<EpiGateUp, MoeOrder, true>(F.lds, DM, F.wave, S, E); } } SEAM(7);
    if (IN(8)) { MoeOrder S{(const LAS int*)(F.lds + LDS_TAB_OFF), F.G, F.vcu, 2, 0, (const char*)(F.ws + WS_HID), (const char*)(F.ws + WS_WD), (const int*)(F.ws + WS_LDST), nullptr, (const float*)(F.ws + WS_LGATE), F.in[I_BD]};
        EpiDown E{F.ws, (const LAS float*)(F.lds + LDS_TAB_OFF) + 2816, (const LAS int*)(F.lds + LDS_TAB_OFF) + 2304, (const LAS float*)(F.lds + LDS_TAB_OFF) + 3072};
        if (PROBE_DUP == 8) { pg8::gemm_phase<EpiDown, MoeOrder, true>(F.lds, DM, F.wave, S, E); __syncthreads(); }
        pg8::gemm_phase<EpiDown, MoeOrder, true>(F.lds, DM, F.wave, S, E); } SEAM(8);
    if (IN(9)) { if (PROBE_DUP == 9) { combine_phase<false>(F); __syncthreads(); } combine_phase<true>(F);
#if defined(PROBE_PH)
        __syncthreads(); PH_STAMP(10);
        if (blockIdx.x == 0 && F.wave == 0 && lane_id() == 0) { const LAS unsigned long long* ts = (const LAS unsigned long long*)(F.lds + LDS_CTL_OFF + 512);
            const float us = (float)(ts[PROBE_PE] - ts[PROBE_PH]) * 0.01f;
#if defined(PROBE_THR)
            F.out[0] = us > PROBE_THR ? 1000.f : 500.f; }
#else
            F.out[0] = rintf(us * (1.f / PROBE_Q)) * PROBE_Q; }
#endif
#endif
#if defined(PROBE_CLK) || defined(PROBE_AT)
        if (F.vcu == 0 && F.wave == 0 && lane_id() == 0) { asm volatile("s_waitcnt vmcnt(0)" ::: "memory"); F.out[0] = ((volatile float*)(F.ws + WS_WRF + 1048576))[0]; }
#endif
    }
#undef IN
#undef SEAM
}

#ifndef MK_N_LAUNCHES
#define MK_N_LAUNCHES 1
#endif
extern "C" void kernel_launch(void* const* d_in, const int* in_sizes, int n_in, void* d_out, int out_size, void* d_ws, size_t ws_size, hipStream_t stream) {
    static int grid = 0;
    if (grid == 0) {
        if (n_in != 22 || in_sizes[0] != T * DM || out_size != T * DM || ws_size < WS_END) { fprintf(stderr, "kernel_launch: unexpected shapes / workspace (n_in %d, ws %zu)\n", n_in, ws_size); grid = -1; return; }
        int dev = 0, cus = 0, per_cu = 0;
        if (hipGetDevice(&dev) != hipSuccess || hipDeviceGetAttribute(&cus, hipDeviceAttributeMultiprocessorCount, dev) != hipSuccess) { grid = -1; return; }
        if (hipFuncSetAttribute((const void*)hymba_fwd, hipFuncAttributeMaxDynamicSharedMemorySize, LDS_BYTES) != hipSuccess) { fprintf(stderr, "kernel_launch: hipFuncSetAttribute failed\n"); grid = -1; return; }
        if (hipOccupancyMaxActiveBlocksPerMultiprocessor(&per_cu, (const void*)hymba_fwd, 512, LDS_BYTES) != hipSuccess || per_cu < 1) fprintf(stderr, "kernel_launch: occupancy query says %d\n", per_cu);
        (void)hipGetLastError();
        grid = cus;
    }
    if (grid < 0) return;
    if (hipMemsetAsync((char*)d_ws + WS_CTL, 0, CTL_ZERO_BYTES, stream) != hipSuccess) return;
    Args a{};
    for (int i = 0; i < 22; ++i) a.in[i] = (const float*)d_in[i];
    a.out = (float*)d_out; a.ws = (unsigned char*)d_ws;
    if (MK_N_LAUNCHES == 1) { a.ph_lo = 0; a.ph_hi = NPHASE; hipLaunchKernelGGL(hymba_fwd, dim3(grid), dim3(512), LDS_BYTES, stream, a); }
    else for (int p = 0; p < NPHASE; ++p) { a.ph_lo = p; a.ph_hi = p + 1; hipLaunchKernelGGL(hymba_fwd, dim3(grid), dim3(512), LDS_BYTES, stream, a); }
}
```

```cpp
#include <hip/hip_runtime.h>
#include <cstdio>
#include <cstdint>

#define LAS __attribute__((address_space(3)))
#define GAS __attribute__((address_space(1)))
typedef unsigned short bf16_t;
typedef short bf16x8 __attribute__((ext_vector_type(8)));
typedef short s16x4 __attribute__((ext_vector_type(4)));
typedef float f32x2 __attribute__((ext_vector_type(2)));
typedef float f32x4 __attribute__((ext_vector_type(4)));
typedef float f32x16 __attribute__((ext_vector_type(16)));
typedef unsigned u32x2 __attribute__((ext_vector_type(2)));
typedef unsigned u32x4 __attribute__((ext_vector_type(4)));
typedef __bf16 bf16x2_t __attribute__((ext_vector_type(2)));
typedef GAS unsigned gu32;

constexpr int NB = 8, SEQ = 8192, DM = 1024, T = NB * SEQ;
constexpr int NIN = 3328;
constexpr int NE = 32, TOPK = 4, DFF = 1024;
constexpr int GLA_C = 64, NCH = SEQ / GLA_C;
constexpr float EPS = 1e-6f;
constexpr float LOG2E = 1.4426950408889634f;

constexpr size_t MiB = 1u << 20;
constexpr size_t WS_CTL = 0, CTL_ZERO_BYTES = 1 * MiB;
constexpr size_t WS_DECAY = 1 * MiB;
constexpr size_t WS_WRF = 2 * MiB;
constexpr size_t WS_WIN = 4 * MiB;
constexpr size_t WS_WOUT = 11 * MiB;
constexpr size_t WS_LDST = 13 * MiB;
constexpr size_t WS_LGATE = 21 * MiB;
constexpr size_t WS_WD = 32 * MiB;
constexpr size_t WS_WGU = 96 * MiB;
constexpr size_t WS_XN = 224 * MiB;
constexpr size_t WS_R = 352 * MiB;
constexpr size_t WS_GQ = WS_R, WS_GK = WS_R + 32 * MiB, WS_GV = WS_R + 64 * MiB, WS_GA = WS_R + 128 * MiB, WS_GR = WS_R + 192 * MiB;
constexpr size_t WS_DQ = WS_R + 256 * MiB, WS_DK = WS_R + 320 * MiB, WS_DV = WS_R + 384 * MiB, WS_KVS = WS_R + 448 * MiB;
constexpr size_t WS_HID = WS_R;
constexpr size_t WS_YS0 = WS_WGU, WS_YS1 = WS_XN, WS_YS2 = 864 * MiB, WS_YS3 = 608 * MiB;
constexpr size_t WS_Y1 = 672 * MiB;
constexpr size_t WS_LRS = 993 * MiB;
constexpr size_t WS_END = 1001 * MiB;
constexpr int CW_TMO = 0, CW_BAR = 4096, CW_G3Q = 12288, CW_CNT = 16384;

constexpr int LDS_BYTES = 147456;
constexpr int LDS_CTL_OFF = 146432;
constexpr int LDS_TAB_OFF = 131072;

#define LDS_WAIT() asm volatile("s_waitcnt lgkmcnt(0)" ::: "memory")
#define VM_WAIT() asm volatile("s_waitcnt vmcnt(0)" ::: "memory")
#define RLX_AGENT __ATOMIC_RELAXED, __HIP_MEMORY_SCOPE_AGENT

__device__ __forceinline__ unsigned cvtpk(float lo, float hi) { f32x2 v = {lo, hi}; bf16x2_t b = __builtin_convertvector(v, bf16x2_t); return __builtin_bit_cast(unsigned, b); }
__device__ __forceinline__ float bf2f(unsigned short b) { return __uint_as_float((unsigned)b << 16); }
__device__ __forceinline__ float bflo(unsigned w) { return __uint_as_float(w << 16); }
__device__ __forceinline__ float bfhi(unsigned w) { return __uint_as_float(w & 0xffff0000u); }
__device__ __forceinline__ float wave_sum(float v) {
#pragma unroll
    for (int o = 1; o < 64; o <<= 1) v += __shfl_xor(v, o);
    return v;
}
__device__ __forceinline__ int lane_id() { int l; asm volatile("v_mbcnt_lo_u32_b32 %0, -1, 0\n\tv_mbcnt_hi_u32_b32 %0, -1, %0" : "=v"(l)); return l; }
__device__ __forceinline__ float fast_exp2(float x) { return __builtin_amdgcn_exp2f(x); }
__device__ __forceinline__ float fast_rcp(float x) { return __builtin_amdgcn_rcpf(x); }
__device__ __forceinline__ float fast_sigmoid(float x) { return fast_rcp(1.0f + fast_exp2(-x * LOG2E)); }

namespace pg8 {
constexpr int BM = 256, BK = 64, HALF = 128, HTB = HALF * BK * 2, STAGE_BYTES = 8 * HTB, NXCD = 8, WGM = 4;
__host__ __device__ __forceinline__ int lds_byte(int r, int c) { const int st = (r >> 4) * 2 + (c >> 5), rr = r & 15, cc = c & 31, ob = rr * 64 + cc * 2; return st * 1024 + (ob ^ (((ob >> 9) & 1) << 5)); }
__host__ __device__ __forceinline__ void stage_rc(int b, int& R, int& C) { const int st = b / 1024, sb = b % 1024, swz = sb ^ (((sb >> 9) & 1) << 5); R = (st >> 1) * 16 + swz / 64; C = (st & 1) * 32 + (swz % 64) / 2; }
__host__ __device__ __forceinline__ int perm32(int rho) { const int n = rho >> 4, i = rho & 15; return 8 * (i >> 2) + 4 * n + (i & 3); }

struct Unit { int pm, pn, rows, row0, lst, e, par; };

struct DenseOrder {
    int nM, nN, nwg, G, c; const char* A; const char* Bt; int RB;
    __device__ __forceinline__ void init(const void* A_, const void* Bt_, int M, int N, int K_, int G_, int c_) { A = (const char*)A_; Bt = (const char*)Bt_; RB = K_ * 2; nM = M / BM; nN = N / BM; nwg = nM * nN; G = G_; c = c_; }
    __device__ __forceinline__ bool next(int i, Unit& u) const {
        const long L = (long)i * G + c; if (L >= nwg) return false;
        int wgid = (int)L; { const int q = nwg / NXCD, r = nwg % NXCD, xcd = wgid % NXCD, off = wgid / NXCD; wgid = (xcd < r ? xcd * (q + 1) : r * (q + 1) + (xcd - r) * q) + off; }
        const int nig = WGM * nN, gid = wgid / nig, fm = gid * WGM, gsz = (nM - fm) < WGM ? (nM - fm) : WGM;
        u.pm = fm + ((wgid % nig) % gsz); u.pn = (wgid % nig) / gsz; u.rows = 256; u.row0 = 0; u.lst = 0; u.e = 0; u.par = 0; return true;
    }
    __device__ __forceinline__ const char* a_base(const Unit& u) const { return A + (size_t)u.pm * (size_t)BM * RB; }
    __device__ __forceinline__ const char* b_base(const Unit& u) const { return Bt + (size_t)u.pn * (size_t)BM * RB; }
    __device__ __forceinline__ void prefetch(const Unit&, int, int, int) const {}
    __device__ __forceinline__ void prefetch_cur(const Unit&, int, int) const {}
    __device__ __forceinline__ void a_off_late(const Unit& u, int, const int (&R)[2], const int (&C)[2], unsigned (&o)[2][2]) const { a_off(u, R, C, o); }
    __device__ __forceinline__ void a_off(const Unit&, const int (&R)[2], const int (&C)[2], unsigned (&o)[2][2]) const {
#pragma unroll
        for (int h = 0; h < 2; ++h)
#pragma unroll
            for (int i = 0; i < 2; ++i) o[h][i] = (unsigned)((h * HALF + R[i]) * RB + C[i] * 2);
    }
};

typedef int v8i32 __attribute__((ext_vector_type(8)));
template <class Epi, class Sched, bool FP8 = false>
__device__ __forceinline__ void gemm_phase(LAS unsigned char* lds, const int RB, const int wid, const Sched& S, const Epi& E) {
    const int lane = lane_id(), tid = wid * 64 + lane, wr = wid >> 2, wc = wid & 3, fr = lane & 15, fq = lane >> 4;
    const int nt = RB / 128;
    int Rr[2], Cc[2]; unsigned voffB[2];
#pragma unroll
    for (int i = 0; i < 2; ++i) { stage_rc(tid * 16 + i * 8192, Rr[i], Cc[i]); const int Rb = Epi::PERM ? ((Rr[i] & ~31) + perm32(Rr[i] & 31)) : Rr[i]; voffB[i] = (unsigned)(Rb * RB + Cc[i] * 2); }
    const size_t kstep = (size_t)(BK * 2);
    const size_t hstep = (size_t)HALF * RB;
    const unsigned ldsw = (unsigned)wid * 1024u;
    const int aoff = lds_byte(wr * 64 + fr, fq * 8), boff = lds_byte(wc * 32 + fr, fq * 8);
#define PG8_SA(b, h) (((b) * 2 + (h)) * HTB)
#define PG8_SB(b, h) ((4 + (b) * 2 + (h)) * HTB)
#define PG8_STAGE(bufoff, gbase, voff) do { _Pragma("unroll") for (int _i = 0; _i < 2; ++_i) { unsigned _o = (voff)[_i]; asm volatile("" : "+v"(_o));     \
        __builtin_amdgcn_global_load_lds((const unsigned*)((const char*)(gbase) + _o), (LAS unsigned*)(lds + (bufoff) + ldsw + _i * 8192), 16, 0, 0); } } while (0)
#define PG8_LDA(dst, b, h) do { _Pragma("unroll") for (int m = 0; m < 4; ++m) _Pragma("unroll") for (int k = 0; k < 2; ++k) dst[m][k] = *(const LAS bf16x8*)(lds + PG8_SA(b, h) + aoff + m * 2048 + k * 1024); } while (0)
#define PG8_LDB(dst, b, h) do { _Pragma("unroll") for (int n = 0; n < 2; ++n) _Pragma("unroll") for (int k = 0; k < 2; ++k) dst[n][k] = *(const LAS bf16x8*)(lds + PG8_SB(b, h) + boff + n * 2048 + k * 1024); } while (0)
#define PG8_CAT(x) __builtin_shufflevector(__builtin_bit_cast(u32x4, (x)[0]), __builtin_bit_cast(u32x4, (x)[1]), 0, 1, 2, 3, 4, 5, 6, 7)
#define PG8_MMA(ai, bj, At, Bt) do { __builtin_amdgcn_s_setprio(1); \
        if constexpr (FP8) { _Pragma("unroll") for (int m = 0; m < 4; ++m) _Pragma("unroll") for (int n = 0; n < 2; ++n) \
            acc[ai][bj][m][n] = __builtin_amdgcn_mfma_scale_f32_16x16x128_f8f6f4(__builtin_bit_cast(v8i32, PG8_CAT(Bt[n])), __builtin_bit_cast(v8i32, PG8_CAT(At[m])), acc[ai][bj][m][n], 0, 0, 0, 0x7f7f7f7f, 0, 0x7f7f7f7f); } \
        else { _Pragma("unroll") for (int m = 0; m < 4; ++m) _Pragma("unroll") for (int n = 0; n < 2; ++n) _Pragma("unroll") for (int k = 0; k < 2; ++k) \
            acc[ai][bj][m][n] = __builtin_amdgcn_mfma_f32_16x16x32_bf16(Bt[n][k], At[m][k], acc[ai][bj][m][n], 0, 0, 0); } \
        __builtin_amdgcn_s_setprio(0); } while (0)
#define PG8_WAIT_V(n) asm volatile("s_waitcnt vmcnt(" #n ")" ::: "memory")
#define PG8_WAIT_L(n) asm volatile("s_waitcnt lgkmcnt(" #n ")" ::: "memory")
#define PG8_BAR __builtin_amdgcn_s_barrier()
#define PG8_SCHED __builtin_amdgcn_sched_barrier(0)
    Unit cur, nxt; int ui = 0;
    if (!S.next(0, cur)) return;
    f32x4 acc[2][2][4][2];
#pragma unroll
    for (int a = 0; a < 2; ++a)
#pragma unroll
        for (int b = 0; b < 2; ++b)
#pragma unroll
            for (int m = 0; m < 4; ++m)
#pragma unroll
                for (int n = 0; n < 2; ++n) acc[a][b][m][n] = (f32x4){0.f, 0.f, 0.f, 0.f};
    bf16x8 At[4][2], B0[2][2], B1[2][2];
    const char* cA = S.a_base(cur); const char* cB = S.b_base(cur);
    unsigned vA[2][2];
    S.a_off(cur, Rr, Cc, vA);
    PG8_STAGE(PG8_SB(0, 0), cB, voffB); PG8_STAGE(PG8_SB(0, 1), cB + hstep, voffB); PG8_STAGE(PG8_SA(0, 0), cA, vA[0]); PG8_STAGE(PG8_SA(0, 1), cA, vA[1]);
    if (wr == 1) PG8_BAR;
    PG8_WAIT_V(2); PG8_BAR;
    PG8_STAGE(PG8_SB(1, 0), cB + kstep, voffB); PG8_STAGE(PG8_SA(1, 0), cA + kstep, vA[0]); PG8_STAGE(PG8_SB(1, 1), cB + hstep + kstep, voffB);
    PG8_WAIT_V(6); PG8_BAR;
    for (;;) {
        const bool has_next = S.next(ui + 1, nxt);
        const char* nA = cA; const char* nB = cB;
        S.prefetch_cur(cur, wid, lane);
        if (has_next) { nA = S.a_base(nxt); nB = S.b_base(nxt); S.prefetch(nxt, ui + 1, wid, lane); }
#pragma unroll 1
        for (int t = 0; t < nt; t += 2) {
            const bool last = (t == nt - 2);
            const char* a1 = cA + (size_t)(t + 1) * kstep;
            const char* a2 = last ? nA : cA + (size_t)(t + 2) * kstep; const char* b2 = last ? nB : cB + (size_t)(t + 2) * kstep;
            const char* a3 = a2 + kstep; const char* b3 = b2 + kstep;
            PG8_STAGE(PG8_SA(1, 1), a1, vA[1]); PG8_SCHED; PG8_LDB(B0, 0, 0); PG8_LDB(B1, 0, 1); PG8_SCHED; PG8_LDA(At, 0, 0);
            if (last && has_next) S.a_off_late(nxt, ui + 1, Rr, Cc, vA);
            PG8_WAIT_V(8); PG8_WAIT_L(0); PG8_BAR; PG8_MMA(0, 0, At, B0); PG8_MMA(0, 1, At, B1); PG8_BAR; PG8_SCHED;
            PG8_STAGE(PG8_SB(0, 0), b2, voffB); PG8_STAGE(PG8_SB(0, 1), b2 + hstep, voffB); PG8_STAGE(PG8_SA(0, 0), a2, vA[0]); PG8_SCHED; PG8_LDA(At, 0, 1);
            PG8_WAIT_V(8); PG8_WAIT_L(0); PG8_BAR; PG8_MMA(1, 0, At, B0); PG8_MMA(1, 1, At, B1); PG8_BAR; PG8_SCHED;
            PG8_STAGE(PG8_SA(0, 1), a2, vA[1]); PG8_SCHED; PG8_LDB(B0, 1, 0); PG8_LDB(B1, 1, 1); PG8_SCHED; PG8_LDA(At, 1, 0);
            PG8_WAIT_V(8); PG8_WAIT_L(0); PG8_BAR; PG8_MMA(0, 0, At, B0); PG8_MMA(0, 1, At, B1); PG8_BAR; PG8_SCHED;
            PG8_STAGE(PG8_SB(1, 0), b3, voffB); PG8_STAGE(PG8_SB(1, 1), b3 + hstep, voffB); PG8_STAGE(PG8_SA(1, 0), a3, vA[0]); PG8_SCHED; PG8_LDA(At, 1, 1);
            PG8_WAIT_V(8); PG8_WAIT_L(0); PG8_BAR; PG8_MMA(1, 0, At, B0); PG8_MMA(1, 1, At, B1); PG8_BAR; PG8_SCHED;
        }
        if (wr == 0) PG8_BAR;
        E(acc, cur, wr, wc, fr, fq);
        if (!has_next) break;
#pragma unroll
        for (int a = 0; a < 2; ++a)
#pragma unroll
            for (int b = 0; b < 2; ++b)
#pragma unroll
                for (int m = 0; m < 4; ++m)
#pragma unroll
                    for (int n = 0; n < 2; ++n) acc[a][b][m][n] = (f32x4){0.f, 0.f, 0.f, 0.f};
        cur = nxt; cA = nA; cB = nB; ++ui;
        if (wr == 1) PG8_BAR;
    }
    PG8_WAIT_V(0);
    PG8_BAR;
#undef PG8_SA
#undef PG8_SB
#undef PG8_STAGE
#undef PG8_LDA
#undef PG8_LDB
#undef PG8_MMA
#undef PG8_CAT
#undef PG8_WAIT_V
#undef PG8_WAIT_L
#undef PG8_BAR
#undef PG8_SCHED
}
}
typedef pg8::Unit Unit;
#define EPI_ROWS(ai, m) (128 * (ai) + 64 * wr + 16 * (m) + fr)

constexpr float WSCALE = 64.f, WSCALE_INV = 1.f / 64.f;
__device__ __forceinline__ unsigned pk4_fp8(float a, float b, float c, float d) { unsigned w = 0u; w = __builtin_amdgcn_cvt_pk_fp8_f32(a, b, w, false); w = __builtin_amdgcn_cvt_pk_fp8_f32(c, d, w, true); return w; }
__device__ __forceinline__ u32x4 pack8(const f32x4& a, const f32x4& b) { u32x4 w; w.x = cvtpk(a[0], a[1]); w.y = cvtpk(a[2], a[3]); w.z = cvtpk(b[0], b[1]); w.w = cvtpk(b[2], b[3]); return w; }

struct EpiInProj {
    static constexpr bool PERM = true;
    unsigned char* ws; const LAS float* bgate; const LAS float* qgain; const LAS float* kgain;
    __device__ __forceinline__ void operator()(const f32x4 (&acc)[2][2][4][2], const Unit& u, int wr, int wc, int fr, int fq) const {
        const int tile = u.pn; const size_t row0 = (size_t)u.pm * 256;
        if (tile == 4) {
            float* GA = (float*)(ws + WS_GA);
#pragma unroll
            for (int bj = 0; bj < 2; ++bj) { const int col = 128 * bj + 32 * wc + 8 * fq;
                const f32x4 b0 = *(const LAS f32x4*)(bgate + col), b1 = *(const LAS f32x4*)(bgate + col + 4);
#pragma unroll
                for (int ai = 0; ai < 2; ++ai)
#pragma unroll
                    for (int m = 0; m < 4; ++m) { f32x4 v0 = acc[ai][bj][m][0] + b0, v1 = acc[ai][bj][m][1] + b1;
#pragma unroll
                        for (int i = 0; i < 4; ++i) { v0[i] = (fminf(v0[i], 0.f) - __logf(1.f + __expf(-fabsf(v0[i])))) * 0.0625f; v1[i] = (fminf(v1[i], 0.f) - __logf(1.f + __expf(-fabsf(v1[i])))) * 0.0625f; }
                        float* p = GA + (row0 + EPI_ROWS(ai, m)) * 256 + col; *(f32x4*)p = v0; *(f32x4*)(p + 4) = v1; } }
        } else if (tile >= 7 && tile <= 10) {
            const bool isq = tile <= 8; const LAS float* gn = isq ? qgain : kgain; const float osc = isq ? 0.125f * LOG2E : 1.0f;
            bf16_t* O = (bf16_t*)(ws + (isq ? WS_DQ : WS_DK)); const int tl = (tile - 7) & 1;
            f32x4 g[2][2];
#pragma unroll
            for (int bj = 0; bj < 2; ++bj)
#pragma unroll
                for (int n = 0; n < 2; ++n) g[bj][n] = *(const LAS f32x4*)(gn + 32 * bj + 8 * fq + 4 * n) * osc;
#pragma unroll
            for (int ai = 0; ai < 2; ++ai)
#pragma unroll
                for (int m = 0; m < 4; ++m) { float ss = 0.f;
#pragma unroll
                    for (int bj = 0; bj < 2; ++bj)
#pragma unroll
                        for (int n = 0; n < 2; ++n) { const f32x4 x = acc[ai][bj][m][n]; ss += (x[0] * x[0] + x[1] * x[1]) + (x[2] * x[2] + x[3] * x[3]); }
                    ss += __shfl_xor(ss, 16); ss += __shfl_xor(ss, 32);
                    const float rs = __builtin_amdgcn_rsqf(ss * (1.f / 64.f) + EPS);
                    bf16_t* p = O + (row0 + EPI_ROWS(ai, m)) * 512 + tl * 256 + 64 * wc + 8 * fq;
#pragma unroll
                    for (int bj = 0; bj < 2; ++bj) *(u32x4*)(p + 32 * bj) = pack8(acc[ai][bj][m][0] * rs * g[bj][0], acc[ai][bj][m][1] * rs * g[bj][1]); }
        } else {
            size_t base; int ld, c0; float sc = 1.f; bool silu = false;
            if (tile == 0) { base = WS_GQ; ld = 256; c0 = 0; sc = 0.125f; }
            else if (tile == 1) { base = WS_GK; ld = 256; c0 = 0; }
            else if (tile <= 3) { base = WS_GV; ld = 512; c0 = (tile - 2) * 256; }
            else if (tile <= 6) { base = WS_GR; ld = 512; c0 = (tile - 5) * 256; silu = true; }
            else { base = WS_DV; ld = 512; c0 = (tile - 11) * 256; }
            bf16_t* O = (bf16_t*)(ws + base);
#pragma unroll
            for (int ai = 0; ai < 2; ++ai)
#pragma unroll
                for (int m = 0; m < 4; ++m) { bf16_t* p = O + (row0 + EPI_ROWS(ai, m)) * ld + c0 + 32 * wc + 8 * fq;
#pragma unroll
                    for (int bj = 0; bj < 2; ++bj) { f32x4 v0 = acc[ai][bj][m][0], v1 = acc[ai][bj][m][1];
                        if (silu) {
#pragma unroll
                            for (int hp = 0; hp < 2; ++hp) { f32x2 a = {v0[2 * hp], v0[2 * hp + 1]}, b = {v1[2 * hp], v1[2 * hp + 1]};
                                const f32x2 ta = a * (-LOG2E), tb = b * (-LOG2E); f32x2 ea, eb; ea.x = fast_exp2(ta.x); ea.y = fast_exp2(ta.y); eb.x = fast_exp2(tb.x); eb.y = fast_exp2(tb.y);
                                const f32x2 da = ea + 1.0f, db = eb + 1.0f; f32x2 ra, rb; ra.x = fast_rcp(da.x); ra.y = fast_rcp(da.y); rb.x = fast_rcp(db.x); rb.y = fast_rcp(db.y);
                                a = a * ra; b = b * rb; v0[2 * hp] = a.x; v0[2 * hp + 1] = a.y; v1[2 * hp] = b.x; v1[2 * hp + 1] = b.y; } }
                        else if (tile == 0) { v0 = v0 * sc; v1 = v1 * sc; }
                        *(u32x4*)(p + 128 * bj) = pack8(v0, v1); } }
        }
    }
};

struct EpiResid {
    static constexpr bool PERM = true;
    bf16_t* y1;
    __device__ __forceinline__ void operator()(const f32x4 (&acc)[2][2][4][2], const Unit& u, int wr, int wc, int fr, int fq) const {
        asm volatile("" : "+v"(fr), "+v"(fq));
#pragma unroll
        for (int ai = 0; ai < 2; ++ai)
#pragma unroll
            for (int m = 0; m < 4; ++m) { bf16_t* p = y1 + ((size_t)u.pm * 256 + EPI_ROWS(ai, m)) * DM + (size_t)u.pn * 256 + 32 * wc + 8 * fq;
#pragma unroll
                for (int bj = 0; bj < 2; ++bj) *(u32x4*)(p + 128 * bj) = pack8(acc[ai][bj][m][0], acc[ai][bj][m][1]); }
    }
};

struct EpiGateUp {
    static constexpr bool PERM = true;
    unsigned char* hid; const LAS float* bls; const LAS float* lrs;
    static __device__ __forceinline__ f32x2 act2(f32x2 accg, f32x2 accl, f32x2 bg, f32x2 bl, float sc) {
        const f32x2 g = accg * sc + bg, l = accl * sc + bl;
        f32x2 a; a.x = fminf(g.x, 7.f); a.y = fminf(g.y, 7.f);
        const f32x2 t = a * (-1.702f * LOG2E);
        f32x2 e; e.x = fast_exp2(t.x); e.y = fast_exp2(t.y);
        const f32x2 d = e + 1.0f;
        f32x2 r; r.x = fast_rcp(d.x); r.y = fast_rcp(d.y);
        f32x2 lc; lc.x = __builtin_amdgcn_fmed3f(l.x, -7.f, 7.f); lc.y = __builtin_amdgcn_fmed3f(l.y, -7.f, 7.f);
        const f32x2 ar = a * r;
        return ar * lc + ar;
    }
    __device__ __forceinline__ void operator()(const f32x4 (&acc)[2][2][4][2], const Unit& u, int wr, int wc, int fr, int fq) const {
        asm volatile("" : "+v"(fr), "+v"(fq));
        const int nt = u.pn & 7, hc = nt * 128 + 32 * wc + 8 * fq;
        const LAS float* bp = bls + (u.par ? 768 : 0) + 32 * wc + 8 * fq;
        const f32x4 bg0 = *(const LAS f32x4*)bp, bg1 = *(const LAS f32x4*)(bp + 4), bl0 = *(const LAS f32x4*)(bp + 128), bl1 = *(const LAS f32x4*)(bp + 132);
        float rsc[2][4];
#pragma unroll
        for (int ai = 0; ai < 2; ++ai)
#pragma unroll
            for (int m = 0; m < 4; ++m) { const int rl = EPI_ROWS(ai, m); rsc[ai][m] = lrs[u.par * 256 + rl] * WSCALE_INV; }
#pragma unroll
        for (int ai = 0; ai < 2; ++ai)
#pragma unroll
            for (int mp = 0; mp < 2; ++mp) { u32x2 wq[2];
#pragma unroll
              for (int q = 0; q < 2; ++q) { const int m = 2 * mp + q; const float sc = rsc[ai][m];
                const f32x4 G0 = acc[ai][0][m][0], G1 = acc[ai][0][m][1], L0 = acc[ai][1][m][0], L1 = acc[ai][1][m][1];
                const f32x2 h0 = act2((f32x2){G0[0], G0[1]}, (f32x2){L0[0], L0[1]}, (f32x2){bg0[0], bg0[1]}, (f32x2){bl0[0], bl0[1]}, sc);
                const f32x2 h1 = act2((f32x2){G0[2], G0[3]}, (f32x2){L0[2], L0[3]}, (f32x2){bg0[2], bg0[3]}, (f32x2){bl0[2], bl0[3]}, sc);
                const f32x2 h2 = act2((f32x2){G1[0], G1[1]}, (f32x2){L1[0], L1[1]}, (f32x2){bg1[0], bg1[1]}, (f32x2){bl1[0], bl1[1]}, sc);
                const f32x2 h3 = act2((f32x2){G1[2], G1[3]}, (f32x2){L1[2], L1[3]}, (f32x2){bg1[2], bg1[3]}, (f32x2){bl1[2], bl1[3]}, sc);
                wq[q].x = pk4_fp8(h0.x, h0.y, h1.x, h1.y); wq[q].y = pk4_fp8(h2.x, h2.y, h3.x, h3.y); }
              const auto rx = __builtin_amdgcn_permlane16_swap(wq[0].x, wq[1].x, false, false); const auto ry = __builtin_amdgcn_permlane16_swap(wq[0].y, wq[1].y, false, false);
              const int odd = fq & 1, rl = EPI_ROWS(ai, 2 * mp + odd);
              if (rl < u.rows) { u32x4 w4; w4.x = rx[0]; w4.y = ry[0]; w4.z = rx[1]; w4.w = ry[1]; *(u32x4*)(hid + ((size_t)u.row0 + rl) * DFF + hc - 8 * odd) = w4; } }
    }
};

constexpr float YSCALE = 16.f, YSCALE_INV = 1.f / 16.f;
struct EpiDown {
    static constexpr bool PERM = true;
    unsigned char* ws; const LAS float* bls; const LAS int* dls; const LAS float* gls;
    __device__ __forceinline__ void operator()(const f32x4 (&acc)[2][2][4][2], const Unit& u, int wr, int wc, int fr, int fq) const {
        asm volatile("" : "+v"(fr), "+v"(fq));
        const int nt = u.pn & 3;
        const int odd = fq & 1;
#pragma unroll
        for (int bj = 0; bj < 2; ++bj) { const size_t col = (size_t)nt * 256 + 128 * bj + 32 * wc + 8 * fq;
            const LAS float* bp = bls + (u.par ? 768 : 0) + 128 * bj + 32 * wc + 8 * fq; const f32x4 b0 = *(const LAS f32x4*)bp, b1 = *(const LAS f32x4*)(bp + 4);
#pragma unroll
            for (int ai = 0; ai < 2; ++ai)
#pragma unroll
                for (int mp = 0; mp < 2; ++mp) { u32x2 wv[2];
#pragma unroll
                    for (int q = 0; q < 2; ++q) { const int m = 2 * mp + q; const float g = gls[u.par * 256 + EPI_ROWS(ai, m)] * YSCALE;
                        const f32x4 y0 = (acc[ai][bj][m][0] * WSCALE_INV + b0) * g, y1 = (acc[ai][bj][m][1] * WSCALE_INV + b1) * g;
                        wv[q].x = pk4_fp8(y0[0], y0[1], y0[2], y0[3]); wv[q].y = pk4_fp8(y1[0], y1[1], y1[2], y1[3]); }
                    const auto rx = __builtin_amdgcn_permlane16_swap(wv[0].x, wv[1].x, false, false); const auto ry = __builtin_amdgcn_permlane16_swap(wv[0].y, wv[1].y, false, false);
                    const int rl = EPI_ROWS(ai, 2 * mp + odd); const int d = dls[u.par * 256 + rl]; const int tok = d >> 2, k = d & 3;
                    const size_t yb = k == 0 ? WS_YS0 : (k == 1 ? WS_YS1 : (k == 2 ? WS_YS2 : WS_YS3));
                    if (rl < u.rows) { u32x4 w4; w4.x = rx[0]; w4.y = ry[0]; w4.z = rx[1]; w4.w = ry[1]; *(u32x4*)(ws + yb + (size_t)tok * DM + col - 8 * odd) = w4; } }
        }
    }
};
struct MoeOrder {
    const LAS int* tab;
    int G, c, NTs, gather;
    const char* A; const char* Bt; const int* ldst; const float* lrs; const float* lgate; const float* bias;
    __device__ __forceinline__ int rd(int i) const { return __builtin_amdgcn_readfirstlane(tab[i]); }
    __device__ __forceinline__ bool next(int i, Unit& u) const {
        const int g = i * G + c, MT = rd(32);
        if (g >= (MT << NTs)) return false;
        const int mtg = g >> NTs, nt = g & ((1 << NTs) - 1);
        const int info = rd(128 + 2 * mtg), row0 = rd(129 + 2 * mtg);
        const int e = info & 31, mt = (info >> 5) & 511;
        u.e = e; u.pm = mt; u.pn = (e << NTs) + nt; u.rows = info >> 14; u.row0 = row0; u.lst = e * 65536 + mt * 256; u.par = i & 1;
        return true;
    }
    __device__ __forceinline__ const char* a_base(const Unit& u) const { return gather ? A : A + (size_t)u.row0 * (size_t)DM; }
    __device__ __forceinline__ const char* b_base(const Unit& u) const { return Bt + (size_t)u.pn * (size_t)256 * DM; }
    __device__ __forceinline__ void a_off(const Unit& u, const int (&R)[2], const int (&C)[2], unsigned (&o)[2][2]) const {
#pragma unroll
        for (int h = 0; h < 2; ++h)
#pragma unroll
            for (int i = 0; i < 2; ++i) { const int rl = h * 128 + R[i];
                if (gather) { const int tok = ldst[u.lst + (rl < u.rows ? rl : 0)] >> 2; o[h][i] = (unsigned)(tok * DM + C[i] * 2); }
                else o[h][i] = (unsigned)(rl * DM + C[i] * 2); }
        if (gather) {
#pragma unroll
            for (int h = 0; h < 2; ++h)
#pragma unroll
                for (int i = 0; i < 2; ++i) asm volatile("" : "+v"(o[h][i])); }
    }
    __device__ __forceinline__ void prefetch(const Unit& u, int ui, int wid, int lane) const {
        if (gather && wid < 4) { const unsigned dst = (unsigned)(uintptr_t)tab + 12288u + (unsigned)(ui & 1) * 1024u + (unsigned)wid * 256u, voff = (unsigned)(u.lst + wid * 64 + lane) * 4u; unsigned keep;
            asm volatile("s_mov_b32 %0, m0\n\ts_mov_b32 m0, %3\n\ts_nop 0\n\tglobal_load_lds_dword %1, %2\n\ts_mov_b32 m0, %0" : "=&s"(keep) : "v"(voff), "s"(ldst), "s"(dst) : "memory"); }
    }
    __device__ __forceinline__ void prefetch_cur(const Unit& u, int wid, int lane) const {
        if (gather && wid >= 4) { const unsigned dst = (unsigned)(uintptr_t)tab + 9216u + (unsigned)u.par * 1024u + (unsigned)(wid - 4) * 256u, voff = (unsigned)(u.lst + (wid - 4) * 64 + lane) * 4u; unsigned keep;
            asm volatile("s_mov_b32 %0, m0\n\ts_mov_b32 m0, %3\n\ts_nop 0\n\tglobal_load_lds_dword %1, %2\n\ts_mov_b32 m0, %0" : "=&s"(keep) : "v"(voff), "s"(lrs), "s"(dst) : "memory"); }
        { const int q = wid & 3, nt = u.pn & ((1 << NTs) - 1);
            const unsigned dstb = (unsigned)(uintptr_t)tab + (u.par ? 14336u : 11264u) + (unsigned)q * 256u; unsigned keep;
            const unsigned voffb = gather ? (unsigned)(u.e * 2048 + (q >> 1) * 1024 + nt * 128 + (q & 1) * 64 + lane) * 4u : (unsigned)(u.e * 1024 + nt * 256 + q * 64 + lane) * 4u;
            if (gather ? wid >= 4 : wid < 4) asm volatile("s_mov_b32 %0, m0\n\ts_mov_b32 m0, %3\n\ts_nop 0\n\tglobal_load_lds_dword %1, %2\n\ts_mov_b32 m0, %0" : "=&s"(keep) : "v"(voffb), "s"(bias), "s"(dstb) : "memory"); }
        if (!gather) { const void* src = wid < 4 ? (const void*)ldst : (const void*)lgate; const int q = wid & 3;
            const unsigned dst = (unsigned)(uintptr_t)tab + (wid < 4 ? 9216u : 12288u) + (unsigned)u.par * 1024u + (unsigned)q * 256u, voff = (unsigned)(u.lst + q * 64 + lane) * 4u; unsigned keep;
            asm volatile("s_mov_b32 %0, m0\n\ts_mov_b32 m0, %3\n\ts_nop 0\n\tglobal_load_lds_dword %1, %2\n\ts_mov_b32 m0, %0" : "=&s"(keep) : "v"(voff), "s"(src), "s"(dst) : "memory"); }
    }
    __device__ __forceinline__ void a_off_late(const Unit& u, int ui, const int (&R)[2], const int (&C)[2], unsigned (&o)[2][2]) const {
        const LAS int* tb = tab + 3072 + (ui & 1) * 256;
#pragma unroll
        for (int h = 0; h < 2; ++h)
#pragma unroll
            for (int i = 0; i < 2; ++i) { const int rl = h * 128 + R[i];
                if (gather) { const int tok = tb[rl < u.rows ? rl : 0] >> 2; o[h][i] = (unsigned)(tok * DM + C[i] * 2); }
                else o[h][i] = (unsigned)(rl * DM + C[i] * 2); }
    }
};
#define XB_TMO      128
#define XB_XCNT(j)  (256  + 64 * (j))
#define XB_XSUB(j)  (1280 + 64 * (j))
#define XB_XGEN(j)  (2304 + 64 * (j))
#define XB_TOP      3328
#define XB_TOPGEN   3392
#define XCD_BAR_WORDS 3456
#define XB_SPIN_CAP (1u << 18)

__device__ __forceinline__ unsigned xb_ld(unsigned* p)              { return __hip_atomic_load(p, __ATOMIC_RELAXED, __HIP_MEMORY_SCOPE_AGENT); }
__device__ __forceinline__ unsigned xb_add(unsigned* p, unsigned v) { return __hip_atomic_fetch_add(p, v, __ATOMIC_RELAXED, __HIP_MEMORY_SCOPE_AGENT); }
__device__ __forceinline__ unsigned xb_xcc_id() { return (unsigned)__builtin_amdgcn_s_getreg((3 << 11) | 20) & 0xFu; }
#define XB_SPIN(cond, bar) do { unsigned _sp = 0; while (cond) { __builtin_amdgcn_s_sleep(1); \
    if ((++_sp & 255u) == 0u) { if (xb_ld(&(bar)[XB_TMO])) break; if (_sp > XB_SPIN_CAP) { atomicAdd(&(bar)[XB_TMO], 1u); break; } } } } while (0)

struct XcdBarrier {
    unsigned* bar; unsigned x; int wave;
    volatile LAS unsigned* st;
};

__device__ __forceinline__ XcdBarrier xcd_barrier_post(unsigned* bar, volatile LAS unsigned* st, int wave) {
    XcdBarrier b; b.bar = bar; b.x = xb_xcc_id(); b.st = st; b.wave = wave;
    if (wave == 0 && lane_id() == 0) (void)xb_add(&bar[XB_XCNT(b.x)], 1u);
    return b;
}
__device__ __forceinline__ void xcd_barrier_complete(unsigned* bar, unsigned x, unsigned& nloc, unsigned& nx) {
    const unsigned G = gridDim.x * gridDim.y * gridDim.z;
    unsigned sum, cnt, mine, sp = 0u;
    for (;;) {
        sum = 0u; cnt = 0u; mine = 0u;
#pragma unroll
        for (unsigned j = 0; j < 16; ++j) { const unsigned c = xb_ld(&bar[XB_XCNT(j)]); sum += c; cnt += (c > 0u) ? 1u : 0u; mine = (j == x) ? c : mine; }
        if (sum == G) break;
        __builtin_amdgcn_s_sleep(1);
        if ((++sp & 255u) == 0u) { if (xb_ld(&bar[XB_TMO])) break; if (sp > XB_SPIN_CAP) { atomicAdd(&bar[XB_TMO], 1u); break; } }
    }
    nloc = mine > 0u ? mine : 1u; nx = cnt > 0u ? cnt : 1u;
}

__device__ __forceinline__ void xcd_barrier(const XcdBarrier& b) {
    asm volatile("s_waitcnt vmcnt(0)" ::: "memory");
    __syncthreads();
    if (b.wave == 0 && lane_id() == 0) {
        unsigned* bar = b.bar;
        __builtin_amdgcn_s_waitcnt(0);
        unsigned nloc = b.st[0], nx = b.st[1];
        if (nloc == 0u) { xcd_barrier_complete(bar, b.x, nloc, nx); b.st[0] = nloc; b.st[1] = nx; }
        const unsigned old = xb_add(&bar[XB_XSUB(b.x)], 1u);
        const unsigned gen = old / nloc;
        if (old + 1u == (gen + 1u) * nloc) {
            __builtin_amdgcn_fence(__ATOMIC_RELEASE, "agent");
            asm volatile("s_waitcnt vmcnt(0)" ::: "memory");
            const unsigned og = xb_add(&bar[XB_TOP], 1u);
            const unsigned tg = og / nx;
            if (og + 1u == (tg + 1u) * nx) xb_add(&bar[XB_TOPGEN], 1u);
            else XB_SPIN(xb_ld(&bar[XB_TOPGEN]) == tg, bar);
            __builtin_amdgcn_fence(__ATOMIC_ACQUIRE, "agent");
            xb_add(&bar[XB_XGEN(b.x)], 1u);
            asm volatile("s_waitcnt vmcnt(0)" ::: "memory");
        } else {
            XB_SPIN(xb_ld(&bar[XB_XGEN(b.x)]) == gen, bar);
            __builtin_amdgcn_fence(__ATOMIC_ACQUIRE, "agent");
            asm volatile("s_waitcnt vmcnt(0)" ::: "memory");
        }
    }
    __syncthreads();
}
struct Frame {
    LAS unsigned char* lds;
    gu32* ctl;
    int wave, vcu, G;
    const float* in[22]; float* out; unsigned char* ws;
};
enum { I_X = 0, I_N1G, I_WIN, I_WG2, I_BG2, I_GOG, I_QG, I_KG, I_LQ1, I_LK1, I_LQ2, I_LK2, I_SUBG, I_RELB, I_WOUT, I_N2G, I_WR, I_BR, I_WGU, I_BGU, I_WD, I_BD };

__device__ __forceinline__ s16x4 tr4(const LAS unsigned char* p) { return __builtin_bit_cast(s16x4, __builtin_amdgcn_ds_read_tr16_b64_v4i16((LAS s16x4*)p)); }
__device__ __forceinline__ bf16x8 cat8(s16x4 lo, s16x4 hi) { return __builtin_shufflevector(lo, hi, 0, 1, 2, 3, 4, 5, 6, 7); }
__device__ __forceinline__ int crow(int r, int hi) { return (r & 3) + 8 * (r >> 2) + 4 * hi; }
#define MFMA32(a, b, c) __builtin_amdgcn_mfma_f32_32x32x16_bf16((a), (b), (c), 0, 0, 0)
__device__ __forceinline__ float swap32(float v) { return __shfl_xor(v, 32); }
__device__ __forceinline__ bf16x8 pack_step(const f32x16& x, int s) {
    u32x4 p; p.x = cvtpk(x[8 * s], x[8 * s + 1]); p.y = cvtpk(x[8 * s + 2], x[8 * s + 3]); p.z = cvtpk(x[8 * s + 4], x[8 * s + 5]); p.w = cvtpk(x[8 * s + 6], x[8 * s + 7]);
    return __builtin_bit_cast(bf16x8, p);
}

__device__ __forceinline__ void p0_tr64(const float* W, int ldw, int ca, int cb, int k0, bf16_t* WT, size_t dst_row0, LAS float* scr, int lane) {
    const int sc = (lane & 32) ? cb + (lane & 31) : ca + (lane & 31);
    const float* src = W + (size_t)k0 * ldw + sc;
#pragma unroll 16
    for (int i = 0; i < 64; ++i) scr[i * 65 + lane] = src[(size_t)i * ldw];
    LDS_WAIT();
    const int c = lane & 7;
#pragma unroll
    for (int j = 0; j < 8; ++j) { const int n = (lane >> 3) + 8 * j; const LAS float* s = scr + (8 * c) * 65 + n;
        u32x4 o; o.x = cvtpk(s[0], s[65]); o.y = cvtpk(s[130], s[195]); o.z = cvtpk(s[260], s[325]); o.w = cvtpk(s[390], s[455]);
        *(u32x4*)(WT + (dst_row0 + n) * 1024 + k0 + 8 * c) = o; }
    LDS_WAIT();
}
__device__ __forceinline__ void p0_tr64_fp8(const float* W, int ldw, int ca, int k0, unsigned char* WT, size_t dst_row0, LAS float* scr, int lane) {
    const float* src = W + (size_t)k0 * ldw + ca + lane;
#pragma unroll 16
    for (int i = 0; i < 64; ++i) scr[i * 65 + lane] = src[(size_t)i * ldw];
    LDS_WAIT();
    const int c = lane & 3;
#pragma unroll
    for (int j = 0; j < 4; ++j) { const int n = (lane >> 2) + 16 * j; const LAS float* s = scr + (16 * c) * 65 + n;
        u32x4 o;
        o.x = pk4_fp8(s[0] * WSCALE, s[65] * WSCALE, s[130] * WSCALE, s[195] * WSCALE); o.y = pk4_fp8(s[260] * WSCALE, s[325] * WSCALE, s[390] * WSCALE, s[455] * WSCALE);
        o.z = pk4_fp8(s[520] * WSCALE, s[585] * WSCALE, s[650] * WSCALE, s[715] * WSCALE); o.w = pk4_fp8(s[780] * WSCALE, s[845] * WSCALE, s[910] * WSCALE, s[975] * WSCALE);
        *(u32x4*)(WT + (dst_row0 + n) * 1024 + k0 + 16 * c) = o; }
    LDS_WAIT();
}
__device__ __forceinline__ int src32_qk(int d) { return 2 * (d & 3) + (d >> 2); }
__device__ __forceinline__ void p0_prologue(Frame& F) {
    LAS float* scr = (LAS float*)(F.lds + F.wave * 16640);
    const int gw = F.vcu * 8 + F.wave, NGW = F.G * 8;
    constexpr int I_A = 48 * 16, I_B = 16 * 16, NITEMS = I_A + I_B;
    bf16_t* WinT = (bf16_t*)(F.ws + WS_WIN); bf16_t* WoutT = (bf16_t*)(F.ws + WS_WOUT);
    for (int it = gw; it < NITEMS; it += NGW) {
        int r = it;
        if (r < I_A) { const int kb = r & 15, idx = r >> 4, dg = idx < 16 ? idx : idx + 4; int ca, cb;
            if (dg < 16) { ca = 64 * dg; cb = ca + 32; }
            else if (dg < 28) { ca = 1040 + 64 * (dg - 20); cb = ca + 32; }
            else if (dg < 44) { const int tl = (dg - 28) >> 2, up = (dg - 28) & 3, base = tl < 2 ? 1552 + 256 * tl : 2064 + 256 * (tl - 2); ca = base + 32 * src32_qk(2 * up); cb = base + 32 * src32_qk(2 * up + 1); }
            else { ca = 2576 + 64 * (dg - 44); cb = ca + 32; }
            p0_tr64(F.in[I_WIN], 3088, ca, cb, 64 * kb, WinT, (size_t)64 * dg, scr, lane_id()); continue; }
        r -= I_A;
        { const int kb = r & 15, g = r >> 4; p0_tr64(F.in[I_WOUT], 1024, 64 * g, 64 * g + 32, 64 * kb, WoutT, (size_t)64 * g, scr, lane_id()); }
    }
    { const int gt = F.vcu * 512 + (F.wave * 64 + lane_id()), NT_ = F.G * 512; const float* w2 = F.in[I_WG2]; const float* win = F.in[I_WIN];
        for (int idx = gt; idx < 256 * 128; idx += NT_) { const int n = idx & 255, kg = idx >> 8; float wv[16];
#pragma unroll
            for (int r = 0; r < 16; ++r) wv[r] = w2[r * 256 + n];
            float o[8];
#pragma unroll
            for (int kk = 0; kk < 8; ++kk) { const float* wp = win + (size_t)(8 * kg + kk) * 3088 + 1024; float a = 0.f;
#pragma unroll
                for (int r = 0; r < 16; ++r) a += wv[r] * wp[r];
                o[kk] = a; }
            u32x4 w; w.x = cvtpk(o[0], o[1]); w.y = cvtpk(o[2], o[3]); w.z = cvtpk(o[4], o[5]); w.w = cvtpk(o[6], o[7]);
            *(u32x4*)(WinT + (size_t)(1024 + n) * 1024 + 8 * kg) = w; }
        const float* wr_ = F.in[I_WR]; bf16_t* wrf = (bf16_t*)(F.ws + WS_WRF);
        for (int idx = gt; idx < 64 * 64; idx += NT_) { const int ks = idx >> 6, ln = idx & 63, e = ln & 31, hh = ln >> 5; float o[8];
#pragma unroll
            for (int j = 0; j < 8; ++j) o[j] = wr_[(16 * ks + 8 * hh + j) * 32 + e];
            u32x4 w; w.x = cvtpk(o[0], o[1]); w.y = cvtpk(o[2], o[3]); w.z = cvtpk(o[4], o[5]); w.w = cvtpk(o[6], o[7]);
            *(u32x4*)(wrf + (size_t)idx * 8) = w; }
    }
    { const float* x = F.in[I_X]; const float* gn = F.in[I_N1G]; bf16_t* XN = (bf16_t*)(F.ws + WS_XN);
        f32x4 g[4];
#pragma unroll
        for (int j = 0; j < 4; ++j) g[j] = *(const f32x4*)(gn + 4 * lane_id() + 256 * j);
        for (int m0 = gw; m0 < T; m0 += 2 * NGW) { f32x4 v[2][4];
#pragma unroll
            for (int r = 0; r < 2; ++r) { const int m = m0 + r * NGW; if (m < T) { const f32x4* xr = (const f32x4*)(x + (size_t)m * DM) + lane_id();
#pragma unroll
                for (int j = 0; j < 4; ++j) v[r][j] = __builtin_nontemporal_load(xr + 64 * j); } }
#pragma unroll
            for (int r = 0; r < 2; ++r) { const int m = m0 + r * NGW; if (m < T) { float s = 0.f;
#pragma unroll
                for (int j = 0; j < 4; ++j) s += (v[r][j].x * v[r][j].x + v[r][j].y * v[r][j].y) + (v[r][j].z * v[r][j].z + v[r][j].w * v[r][j].w);
                const float rs = __builtin_amdgcn_rsqf(wave_sum(s) * (1.f / DM) + EPS);
                u32x2* o8 = (u32x2*)(XN + (size_t)m * DM) + lane_id();
#pragma unroll
                for (int j = 0; j < 4; ++j) { const f32x4 y = v[r][j] * rs * g[j]; u32x2 w; w.x = cvtpk(y.x, y.y); w.y = cvtpk(y.z, y.w); o8[64 * j] = w; } } } }
    }
}

template <bool WB>
__device__ __forceinline__ void gla_g01(Frame& F) {
    LAS unsigned char* L = F.lds;
    LAS float* LA = (LAS float*)L; LAS float* PART = (LAS float*)(L + 16384); LAS unsigned char* KR = L + 18432; LAS unsigned char* VL = L + 27136;
    const float* GA = (const float*)(F.ws + WS_GA); bf16_t* GQ = (bf16_t*)(F.ws + WS_GQ); bf16_t* GK = (bf16_t*)(F.ws + WS_GK); const bf16_t* GV = (const bf16_t*)(F.ws + WS_GV);
    bf16_t* KVS = (bf16_t*)(F.ws + WS_KVS); float* DEC = (float*)(F.ws + WS_DECAY);
    const int tid = (F.wave * 64 + lane_id()), lane = lane_id(), w = F.wave;
    const int d = tid & 63, part = tid >> 6;
    f32x4 ga[2]; u32x4 gv[2]; bf16_t qv[8], kv[8];
#define G01_LOAD(uu) do { const int n_ = (uu) & 127, bh_ = (uu) >> 7, h_ = bh_ & 3, b_ = bh_ >> 2; const size_t r_ = (size_t)b_ * SEQ + 64 * n_; \
        _Pragma("unroll") for (int p = 0; p < 2; ++p) { const int idx = tid + 512 * p, t = idx >> 4, c = idx & 15; ga[p] = *(const f32x4*)(GA + (r_ + t) * 256 + h_ * 64 + 4 * c); gv[p] = *(const u32x4*)(GV + (r_ + t) * 512 + h_ * 128 + 8 * c); } \
        _Pragma("unroll") for (int i = 0; i < 8; ++i) { const size_t gi = (r_ + 8 * part + i) * 256 + h_ * 64 + d; qv[i] = GQ[gi]; kv[i] = GK[gi]; } } while (0)
    if (F.vcu < 4096) G01_LOAD(F.vcu);
    for (int u = F.vcu; u < 4096; u += F.G) {
        const int n = u & 127, bh = u >> 7, h = bh & 3, b = bh >> 2; const size_t row0 = (size_t)b * SEQ + 64 * n;
#pragma unroll
        for (int p = 0; p < 2; ++p) { const int idx = tid + 512 * p, t = idx >> 4, c = idx & 15;
            *(LAS f32x4*)(LA + t * 64 + 4 * c) = ga[p];
            *(LAS u32x4*)(VL + t * 272 + 16 * c) = gv[p]; }
        __syncthreads();
        float cs[8]; float run = 0.f;
#pragma unroll
        for (int i = 0; i < 8; ++i) { run += LA[(8 * part + i) * 64 + d]; cs[i] = run; }
        PART[part * 64 + d] = run;
        __syncthreads();
        float offs = 0.f, tot = 0.f;
#pragma unroll
        for (int p = 0; p < 8; ++p) { const float v = PART[p * 64 + d]; tot += v; if (p < part) offs += v; }
#pragma unroll
        for (int i = 0; i < 8; ++i) { const int t = 8 * part + i; const float bb = offs + cs[i]; const size_t gi = (row0 + t) * 256 + h * 64 + d;
            const float q = bf2f(qv[i]), k = bf2f(kv[i]);
            const float eb = __expf(bb), kd = k * __expf(-bb), kr = k * __expf(tot - bb);
            if (WB) { GQ[gi] = (bf16_t)(cvtpk(q * eb, 0.f) & 0xffffu); GK[gi] = (bf16_t)(cvtpk(kd, 0.f) & 0xffffu); } else { ((bf16_t*)(F.ws + WS_YS2))[gi] = (bf16_t)(cvtpk(q * eb, 0.f) & 0xffffu); ((bf16_t*)(F.ws + WS_YS2 + 33554432))[gi] = (bf16_t)(cvtpk(kd, 0.f) & 0xffffu); }
            *(LAS bf16_t*)(KR + t * 136 + 2 * d) = (bf16_t)(cvtpk(kr, 0.f) & 0xffffu); }
        if (part == 0) DEC[(size_t)u * 64 + d] = __expf(tot);
        __syncthreads();
        if (u + F.G < 4096) G01_LOAD(u + F.G);
        { const int db = w & 1, eb = w >> 1, hh = lane >> 5, blk = (lane >> 4) & 1, q4 = (lane & 15) >> 2, p4 = lane & 3;
            f32x16 acc; for (int i = 0; i < 16; ++i) acc[i] = 0.f;
#pragma unroll
            for (int ks = 0; ks < 4; ++ks) { const int r0 = 16 * ks + 8 * hh + q4;
                const bf16x8 a = cat8(tr4(KR + r0 * 136 + (32 * db + 16 * blk + 4 * p4) * 2), tr4(KR + (r0 + 4) * 136 + (32 * db + 16 * blk + 4 * p4) * 2));
                const bf16x8 bb = cat8(tr4(VL + r0 * 272 + (32 * eb + 16 * blk + 4 * p4) * 2), tr4(VL + (r0 + 4) * 272 + (32 * eb + 16 * blk + 4 * p4) * 2));
                acc = MFMA32(a, bb, acc); }
            bf16_t* o = KVS + ((size_t)u * 64 + 32 * db) * 128 + 32 * eb + (lane & 31);
#pragma unroll
            for (int i = 0; i < 16; ++i) o[(size_t)crow(i, hh) * 128] = (bf16_t)(cvtpk(acc[i], 0.f) & 0xffffu); }
        __syncthreads();
    }
#undef G01_LOAD
}
template <bool REAL>
__device__ __forceinline__ void gla_scan(Frame& F) {
    unsigned* KVS = (unsigned*)(F.ws + WS_KVS); unsigned* KVO = REAL ? KVS : (unsigned*)(F.ws + WS_YS2); const float* DEC = (const float*)(F.ws + WS_DECAY);
    for (int g = F.vcu * 512 + (F.wave * 64 + lane_id()); g < 32 * 64 * 64; g += F.G * 512) { const int e2 = g & 63, d = (g >> 6) & 63, bh = g >> 12;
        float s0 = 0.f, s1 = 0.f;
        for (int n0 = 0; n0 < 128; n0 += 8) { unsigned kv[8]; float dc[8];
#pragma unroll
            for (int i = 0; i < 8; ++i) { const size_t u = (size_t)bh * 128 + n0 + i; kv[i] = KVS[(u * 64 + d) * 64 + e2]; dc[i] = DEC[u * 64 + d]; }
#pragma unroll
            for (int i = 0; i < 8; ++i) { const size_t u = (size_t)bh * 128 + n0 + i; KVO[(u * 64 + d) * 64 + e2] = cvtpk(s0, s1); s0 = s0 * dc[i] + bflo(kv[i]); s1 = s1 * dc[i] + bfhi(kv[i]); } }
    }
}
__device__ __forceinline__ void gla_g3(Frame& F) {
    LAS unsigned char* L = F.lds;
    LAS unsigned char* QD = L; LAS unsigned char* KD = L + 9216; LAS unsigned char* VL = L + 18432; LAS unsigned char* ST = L + 35840; LAS unsigned char* GRs = L + 53248; LAS unsigned char* OUT = L + 70656;
    LAS float* SS = (LAS float*)(L + 88064); LAS float* OG = (LAS float*)(L + 90112);
    const bf16_t* GQ = (const bf16_t*)(F.ws + WS_GQ); const bf16_t* GK = (const bf16_t*)(F.ws + WS_GK); const bf16_t* GV = (const bf16_t*)(F.ws + WS_GV); const bf16_t* GR = (const bf16_t*)(F.ws + WS_GR);
    const bf16_t* KVS = (const bf16_t*)(F.ws + WS_KVS); bf16_t* Y = (bf16_t*)(F.ws + WS_XN);
    { const int t_ = F.wave * 64 + lane_id(); if (t_ < 128) OG[t_] = F.in[I_GOG][t_]; }
    const int tid = (F.wave * 64 + lane_id()), lane = lane_id(), w = F.wave, tb = w & 1, eb = w >> 1, hh = lane >> 5, l31 = lane & 31, blk = (lane >> 4) & 1, q4 = (lane & 15) >> 2, p4 = lane & 3;
    u32x4 pq, pk, pv[2], ps[2], pr[2];
#define G3_LOAD(uu) do { const int n_ = (uu) & 127, bh_ = (uu) >> 7, h_ = bh_ & 3, b_ = bh_ >> 2; const size_t r_ = (size_t)b_ * SEQ + 64 * n_; \
        { const int t = tid >> 3, c = tid & 7; pq = *(const u32x4*)(GQ + (r_ + t) * 256 + h_ * 64 + 8 * c); pk = *(const u32x4*)(GK + (r_ + t) * 256 + h_ * 64 + 8 * c); } \
        _Pragma("unroll") for (int p = 0; p < 2; ++p) { const int idx = tid + 512 * p, t = idx >> 4, c = idx & 15; \
            pv[p] = *(const u32x4*)(GV + (r_ + t) * 512 + h_ * 128 + 8 * c); ps[p] = *(const u32x4*)(KVS + ((size_t)(uu) * 64 + t) * 128 + 8 * c); pr[p] = *(const u32x4*)(GR + (r_ + t) * 512 + h_ * 128 + 8 * c); } } while (0)
    LAS int* UQ = (LAS int*)(L + 90112 + 512);
    __syncthreads();
    if (tid == 0) { UQ[0] = (int)__hip_atomic_fetch_add(F.ctl + CW_G3Q, 1u, __ATOMIC_RELAXED, __HIP_MEMORY_SCOPE_AGENT); UQ[1] = (int)__hip_atomic_fetch_add(F.ctl + CW_G3Q, 1u, __ATOMIC_RELAXED, __HIP_MEMORY_SCOPE_AGENT); }
    __syncthreads();
    int u = UQ[0], un = UQ[1];
    if (u < 4096) G3_LOAD(u);
    for (; u < 4096; ) {
        const int n = u & 127, bh = u >> 7, h = bh & 3, b = bh >> 2; const size_t row0 = (size_t)b * SEQ + 64 * n;
        { const int t = tid >> 3, c = tid & 7;
            *(LAS u32x4*)(QD + t * 144 + 16 * c) = pq;
            *(LAS u32x4*)(KD + t * 144 + 16 * c) = pk; }
#pragma unroll
        for (int p = 0; p < 2; ++p) { const int idx = tid + 512 * p, t = idx >> 4, c = idx & 15;
            *(LAS u32x4*)(VL + t * 272 + 16 * c) = pv[p];
            *(LAS u32x4*)(ST + t * 272 + 16 * c) = ps[p];
            *(LAS u32x4*)(GRs + t * 272 + 16 * c) = pr[p]; }
        __syncthreads();
        if (un < 4096) G3_LOAD(un);
        if (tid == 0) UQ[2] = (int)__hip_atomic_fetch_add(F.ctl + CW_G3Q, 1u, __ATOMIC_RELAXED, __HIP_MEMORY_SCOPE_AGENT);
        bf16x8 qf[4];
#pragma unroll
        for (int ks = 0; ks < 4; ++ks) qf[ks] = *(const LAS bf16x8*)(QD + (32 * tb + l31) * 144 + (16 * ks + 8 * hh) * 2);
        f32x16 o; for (int i = 0; i < 16; ++i) o[i] = 0.f;
#pragma unroll
        for (int sb = 0; sb < 2; ++sb) { f32x16 at; for (int i = 0; i < 16; ++i) at[i] = 0.f;
#pragma unroll
            for (int ks = 0; ks < 4; ++ks) at = MFMA32(*(const LAS bf16x8*)(KD + (32 * sb + l31) * 144 + (16 * ks + 8 * hh) * 2), qf[ks], at);
#pragma unroll
            for (int i = 0; i < 16; ++i) if (32 * sb + crow(i, hh) > 32 * tb + l31) at[i] = 0.f;
#pragma unroll
            for (int s2 = 0; s2 < 2; ++s2) { const int r0 = 32 * sb + 16 * s2 + 4 * hh + q4;
                const bf16x8 va = cat8(tr4(VL + r0 * 272 + (32 * eb + 16 * blk + 4 * p4) * 2), tr4(VL + (r0 + 8) * 272 + (32 * eb + 16 * blk + 4 * p4) * 2));
                o = MFMA32(va, pack_step(at, s2), o); } }
#pragma unroll
        for (int ks = 0; ks < 4; ++ks) { const int r0 = 16 * ks + 8 * hh + q4;
            const bf16x8 sa = cat8(tr4(ST + r0 * 272 + (32 * eb + 16 * blk + 4 * p4) * 2), tr4(ST + (r0 + 4) * 272 + (32 * eb + 16 * blk + 4 * p4) * 2));
            o = MFMA32(sa, qf[ks], o); }
        float ss = 0.f;
#pragma unroll
        for (int i = 0; i < 16; ++i) ss += o[i] * o[i];
        ss += swap32(ss);
        if (hh == 0) SS[eb * 64 + 32 * tb + l31] = ss;
        __syncthreads();
        { const int t = 32 * tb + l31; const float tot = (SS[t] + SS[64 + t]) + (SS[128 + t] + SS[192 + t]); const float rs = __builtin_amdgcn_rsqf(tot * (1.f / 128.f) + EPS);
#pragma unroll
            for (int g4 = 0; g4 < 4; ++g4) { const int e = 32 * eb + 8 * g4 + 4 * hh; const u32x2 rr = *(const LAS u32x2*)(GRs + t * 272 + e * 2); const f32x4 gg = *(const LAS f32x4*)(OG + e);
                u32x2 wv; wv.x = cvtpk(o[4 * g4] * rs * gg[0] * bflo(rr.x), o[4 * g4 + 1] * rs * gg[1] * bfhi(rr.x)); wv.y = cvtpk(o[4 * g4 + 2] * rs * gg[2] * bflo(rr.y), o[4 * g4 + 3] * rs * gg[3] * bfhi(rr.y));
                *(LAS u32x2*)(OUT + t * 272 + e * 2) = wv; } }
        __syncthreads();
#pragma unroll
        for (int p = 0; p < 2; ++p) { const int idx = tid + 512 * p, t = idx >> 4, c = idx & 15;
            *(u32x4*)(Y + (row0 + t) * DM + h * 128 + 8 * c) = *(const LAS u32x4*)(OUT + t * 272 + 16 * c); }
        u = un; un = UQ[2];
        __syncthreads();
    }
#undef G3_LOAD
}
constexpr int AT_KB = 16384, AT_VB = 16384;
constexpr int AT_K0 = 0, AT_V0 = 3 * AT_KB, AT_XCH = 65536, AT_BIAS = LDS_TAB_OFF, AT_LAM = AT_BIAS + 512, AT_OSTR = 272;
constexpr float AT_THR = 8.f;
__device__ __forceinline__ float max3f(float a, float b, float c) { float r; asm("v_max3_f32 %0, %1, %2, %3" : "=v"(r) : "v"(a), "v"(b), "v"(c)); return r; }
__device__ __forceinline__ float xmax32(float v) { auto rr = __builtin_amdgcn_permlane32_swap(__float_as_uint(v), __float_as_uint(v), false, false); return max3f(__uint_as_float(rr[0]), __uint_as_float(rr[1]), v); }
__device__ __forceinline__ float xsum32(float v) { auto rr = __builtin_amdgcn_permlane32_swap(__float_as_uint(v), __float_as_uint(v), false, false); return __uint_as_float(rr[0]) + __uint_as_float(rr[1]); }
__device__ __forceinline__ void at_dma(const void* gbase, unsigned voff, unsigned lds_dst) { unsigned keep;
    asm volatile("s_mov_b32 %0, m0\n\ts_mov_b32 m0, %3\n\ts_nop 0\n\tglobal_load_lds_dwordx4 %1, %2\n\ts_mov_b32 m0, %0" : "=&s"(keep) : "v"(voff), "s"(gbase), "s"(lds_dst) : "memory"); }
__device__ __forceinline__ const bf16_t* uni_ptr(const bf16_t* p) { const unsigned long long v = (unsigned long long)p; const unsigned lo = __builtin_amdgcn_readfirstlane((unsigned)v), hi = __builtin_amdgcn_readfirstlane((unsigned)(v >> 32)); return (const bf16_t*)(((unsigned long long)hi << 32) | lo); }
#define AT_WAITBAR() asm volatile("s_waitcnt vmcnt(0) lgkmcnt(0)\n\ts_barrier" ::: "memory")
#define AT_WAITBAR4() asm volatile("s_waitcnt vmcnt(4) lgkmcnt(0)\n\ts_barrier" ::: "memory")
#define AT_VFR(dst, Vb, kst) do { _Pragma("unroll") for (int eb = 0; eb < 4; ++eb) dst[eb] = cat8(tr4((Vb) + vb0 + (kst) * 4096 + eb * 512), tr4((Vb) + vb1 + (kst) * 4096 + eb * 512)); } while (0)
#define AT_PV(Vb, PF) do { _Pragma("unroll") for (int kst = 0; kst < 4; ++kst) { bf16x8 vf_[4]; AT_VFR(vf_, Vb, kst); \
        _Pragma("unroll") for (int eb = 0; eb < 4; ++eb) o[eb] = MFMA32(vf_[eb], PF[kst], o[eb]); } } while (0)
#define AT_QK(S0, S1, Kb) do { if constexpr (SAFE) { S0 = MFMA32(*(const LAS bf16x8*)((Kb) + kofs[0]), qf[0], zero16); S1 = MFMA32(*(const LAS bf16x8*)((Kb) + kofs[0] + 4096), qf[0], zero16); } \
        else { S0 = MFMA32(*(const LAS bf16x8*)((Kb) + kofs[0]), qf[0], negm); S1 = MFMA32(*(const LAS bf16x8*)((Kb) + kofs[0] + 4096), qf[0], negm); } \
        _Pragma("unroll") for (int ks = 1; ks < 4; ++ks) { S0 = MFMA32(*(const LAS bf16x8*)((Kb) + kofs[ks]), qf[ks], S0); S1 = MFMA32(*(const LAS bf16x8*)((Kb) + kofs[ks] + 4096), qf[ks], S1); } } while (0)
constexpr int AT_CV = 98304, CV_TOTAL = 65536 + 32768;
__device__ __forceinline__ void cv_decode(const Frame& F, int idx, const float*& src, int& ldw, unsigned char*& dst) {
    if (idx < 65536) { const int k16 = idx & 63, grp = (idx >> 6) & 31, e = idx >> 11, nt = grp >> 2, bj = (grp >> 1) & 1, hf = grp & 1, ca = bj * 1024 + nt * 128 + 64 * hf;
        src = F.in[I_WGU] + (size_t)e * 1024 * 2048 + (size_t)(16 * k16) * 2048 + ca; ldw = 2048; dst = F.ws + WS_WGU + ((size_t)e * 2048 + 64 * grp) * 1024 + 16 * k16; }
    else { const int r = idx - 65536, k16 = r & 63, g = (r >> 6) & 15, e = r >> 10;
        src = F.in[I_WD] + (size_t)e * 1024 * 1024 + (size_t)(16 * k16) * 1024 + 64 * g; ldw = 1024; dst = F.ws + WS_WD + ((size_t)e * 1024 + 64 * g) * 1024 + 16 * k16; }
}
__device__ __forceinline__ void cv_issue(const Frame& F, int idx, unsigned lds_dst, int lane) {
    const float* src; int ldw; unsigned char* dst; cv_decode(F, idx, src, ldw, dst);
    const bf16_t* g = uni_ptr((const bf16_t*)src);
#pragma unroll
    for (int j = 0; j < 4; ++j) at_dma(g, (unsigned)(((4 * j + (lane >> 4)) * ldw + 4 * (lane & 15)) * 4), lds_dst + j * 1024);
}
__device__ __forceinline__ void cv_convert(const Frame& F, int idx, const LAS float* scr, int lane) {
    const float* src; int ldw; unsigned char* dst; cv_decode(F, idx, src, ldw, dst);
    float v[16];
#pragma unroll
    for (int i = 0; i < 16; ++i) v[i] = scr[i * 64 + lane] * WSCALE;
    u32x4 o; o.x = pk4_fp8(v[0], v[1], v[2], v[3]); o.y = pk4_fp8(v[4], v[5], v[6], v[7]); o.z = pk4_fp8(v[8], v[9], v[10], v[11]); o.w = pk4_fp8(v[12], v[13], v[14], v[15]);
    *(u32x4*)(dst + (size_t)lane * 1024) = o;
}
#define AT_CVSTEP() do { if (cv_cur >= 0) { cv_convert(F, cv_cur, (const LAS float*)(L + AT_CV + w * 4096), lane); cv_cur = -1; } \
    if (cv_idx < cv_end && ((++cv_tick) & 7) == 0) { cv_issue(F, cv_idx, lds0 + AT_CV + w * 4096, lane); cv_cur = cv_idx; ++cv_idx; } } while (0)
#define AT_HEAD(i) do { AT_CVSTEP(); \
    if ((i) + 3 < NT) { const bf16_t* gk_ = uni_ptr(DKu + (size_t)((i) + 3) * 64 * 512); at_dma(gk_, kvo[0], lds0 + AT_K0 + k0 + w * 1024); at_dma(gk_, kvo[1], lds0 + AT_K0 + k0 + 8192 + w * 1024); } \
    if ((i) + 1 < NT) { const bf16_t* gv_ = uni_ptr(DVu + (size_t)((i) + 1) * 64 * 512); at_dma(gv_, vvo[0], lds0 + AT_V0 + vnext + w * 1024); at_dma(gv_, vvo[1], lds0 + AT_V0 + vnext + 8192 + w * 1024); } } while (0)
#define AT_HEAD_FAR(i) do { AT_CVSTEP(); \
    { const bf16_t* gk_ = uni_ptr(DKu + (size_t)((i) + 3) * 64 * 512); at_dma(gk_, kvo[0], lds0 + AT_K0 + k0 + w * 1024); at_dma(gk_, kvo[1], lds0 + AT_K0 + k0 + 8192 + w * 1024); } \
    { const bf16_t* gv_ = uni_ptr(DVu + (size_t)((i) + 1) * 64 * 512); at_dma(gv_, vvo[0], lds0 + AT_V0 + vnext + w * 1024); at_dma(gv_, vvo[1], lds0 + AT_V0 + vnext + 8192 + w * 1024); } } while (0)
#define AT_BANDFIX(i, S0, S1) do { const int d0_ = qpos - 64 * (i);                  \
            float b0_[16], b1_[16]; \
            _Pragma("unroll") for (int r_ = 0; r_ < 16; ++r_) { const int dd_ = d0_ - crow(r_, hh), d2_ = dd_ - 32; b0_[r_] = BT[min(max(dd_, 0), 127)]; b1_[r_] = BT[min(max(d2_, 0), 127)]; } \
            _Pragma("unroll") for (int r_ = 0; r_ < 16; ++r_) { const int dd_ = d0_ - crow(r_, hh), d2_ = dd_ - 32; S0[r_] = dd_ < 0 ? -1e30f : S0[r_] + b0_[r_]; S1[r_] = d2_ < 0 ? -1e30f : S1[r_] + b1_[r_]; } } while (0)
#define AT_CORE(i, S0, S1, PF) do { \
        if constexpr (!SAFE) { \
        float mx_ = max3f(S0[0], S1[0], S0[1]); mx_ = max3f(mx_, S1[1], S0[2]); \
        _Pragma("unroll") for (int r_ = 3; r_ < 15; r_ += 2) { mx_ = max3f(mx_, S0[r_], S1[r_ - 1]); mx_ = max3f(mx_, S0[r_ + 1], S1[r_]); } \
        mx_ = max3f(mx_, S0[15], S1[14]); mx_ = xmax32(fmaxf(mx_, S1[15])); \
        if (__any(mx_ > AT_THR)) {                                                   \
            { const LAS unsigned char* Vp_ = L + AT_V0 + vprev; AT_PV(Vp_, PF); } \
            _Pragma("unroll") for (int k_ = 0; k_ < 4; ++k_) PF[k_] = (bf16x8){0, 0, 0, 0, 0, 0, 0, 0}; \
            const float dl_ = fmaxf(mx_, 0.f), al_ = fast_exp2(-dl_); lrun *= al_; mref += dl_; \
            _Pragma("unroll") for (int r_ = 0; r_ < 16; ++r_) { negm[r_] = -mref; S0[r_] -= dl_; S1[r_] -= dl_; } \
            _Pragma("unroll") for (int eb = 0; eb < 4; ++eb) _Pragma("unroll") for (int r_ = 0; r_ < 16; ++r_) o[eb][r_] *= al_; } \
        } \
        { const LAS unsigned char* Vp_ = L + AT_V0 + vprev; AT_PV(Vp_, PF); } \
        float pa_ = 0.f, pb_ = 0.f; \
        _Pragma("unroll") for (int r_ = 0; r_ < 16; ++r_) { S0[r_] = fast_exp2(S0[r_]); S1[r_] = fast_exp2(S1[r_]); pa_ += S0[r_]; pb_ += S1[r_]; } \
        lrun += pa_ + pb_; \
        PF[0] = pack_step(S0, 0); PF[1] = pack_step(S0, 1); PF[2] = pack_step(S1, 0); PF[3] = pack_step(S1, 1); \
        { const LAS unsigned char* Kb_ = L + AT_K0 + k1; AT_QK(S0, S1, Kb_); } } while (0)
#define SBAR() __builtin_amdgcn_sched_barrier(0)
#define PINV(x) asm volatile("" : "+v"(x))
#define AT_VRD(n) do { vl[n] = tr4(va0_ + ((n) >> 2) * 4096 + ((n) & 3) * 512); vh[n] = tr4(va1_ + ((n) >> 2) * 4096 + ((n) & 3) * 512); } while (0)
#define AT_VF(n) cat8(vl[n], vh[n])
#define AT_PVM(n) o[(n) & 3] = MFMA32(AT_VF(n), __builtin_bit_cast(bf16x8, pw[(n) >> 2]), o[(n) & 3])
#define AT_GX(n, X, j) do { AT_VRD((n) + 2); SBAR(); AT_PVM(n); \
    X[j] = fast_exp2(X[j]); X[(j) + 1] = fast_exp2(X[(j) + 1]); X[(j) + 2] = fast_exp2(X[(j) + 2]); X[(j) + 3] = fast_exp2(X[(j) + 3]); PINV(X); SBAR(); } while (0)
#define AT_KRD(m) kf[m] = *(const LAS bf16x8*)(ka_[(m) >> 1] + ((m) & 1) * 4096)
#define AT_GS(n, X, j, k, e, RD) do { RD; AT_KRD((n) - 8); SBAR(); AT_PVM(n); \
    sa_ += X[j]; sb_ += X[(j) + 1]; sa_ += X[(j) + 2]; sb_ += X[(j) + 3]; pw[k][e] = cvtpk(X[j], X[(j) + 1]); pw[k][(e) + 1] = cvtpk(X[(j) + 2], X[(j) + 3]); PINV(pw[k]); PINV(sa_); PINV(sb_); SBAR(); } while (0)
#define AT_GA(n, X, j) do { AT_KRD((n) - 8); SBAR(); AT_PVM(n); sa_ += X[j]; sb_ += X[(j) + 1]; sa_ += X[(j) + 2]; sb_ += X[(j) + 3]; PINV(sa_); PINV(sb_); SBAR(); } while (0)
#define AT_E3(X, j) do { X[j] = fast_exp2(X[j]); X[(j) + 1] = fast_exp2(X[(j) + 1]); X[(j) + 2] = fast_exp2(X[(j) + 2]); PINV(X); } while (0)
#define AT_A4C(X, j, k, e) do { sa_ += X[j]; sb_ += X[(j) + 1]; sa_ += X[(j) + 2]; sb_ += X[(j) + 3]; pw[k][e] = cvtpk(X[j], X[(j) + 1]); pw[k][(e) + 1] = cvtpk(X[(j) + 2], X[(j) + 3]); PINV(pw[k]); PINV(sa_); PINV(sb_); } while (0)
#define AT_A2C(X, j, k, e) do { sa_ += X[j]; sb_ += X[(j) + 1]; pw[k][e] = cvtpk(X[j], X[(j) + 1]); PINV(pw[k]); PINV(sa_); PINV(sb_); } while (0)
#define AT_CORE_H(i, S0, S1, D0, D1, D2, D3) do { \
    const LAS unsigned char* va0_ = L + AT_V0 + vprev + vb0; const LAS unsigned char* va1_ = L + AT_V0 + vprev + vb1; \
    const LAS unsigned char* ka_[4]; _Pragma("unroll") for (int ks = 0; ks < 4; ++ks) ka_[ks] = L + AT_K0 + k1 + kofs[ks]; \
    float sa_ = 0.f, sb_ = 0.f; bf16x8 kf[8]; SBAR(); \
    S0[0] = fast_exp2(S0[0]); S0[1] = fast_exp2(S0[1]); S0[2] = fast_exp2(S0[2]); S0[3] = fast_exp2(S0[3]); PINV(S0); SBAR();        \
    AT_VRD(2); SBAR(); AT_PVM(0); AT_E3(S0, 4); SBAR();  AT_VRD(3); SBAR(); AT_PVM(1); AT_E3(S0, 7); SBAR();  AT_VRD(4); SBAR(); AT_PVM(2); AT_E3(S0, 10); SBAR(); AT_VRD(5); SBAR(); AT_PVM(3); AT_E3(S0, 13); SBAR(); \
    AT_VRD(6); SBAR(); AT_PVM(4); AT_E3(S1, 0); SBAR();  AT_VRD(7); SBAR(); AT_PVM(5); AT_E3(S1, 3); SBAR();  AT_VRD(8); SBAR(); AT_PVM(6); AT_E3(S1, 6); SBAR();  AT_VRD(9); SBAR(); AT_PVM(7); AT_E3(S1, 9); SBAR(); \
    AT_VRD(10); SBAR(); AT_PVM(8); S1[12] = fast_exp2(S1[12]); S1[13] = fast_exp2(S1[13]); PINV(S1); AT_A2C(S0, 0, 0, 0); SBAR(); \
    AT_VRD(11); SBAR(); AT_PVM(9); S1[14] = fast_exp2(S1[14]); S1[15] = fast_exp2(S1[15]); PINV(S1); AT_A2C(S0, 2, 0, 1); SBAR(); \
    AT_VRD(12); SBAR(); AT_PVM(10); AT_A4C(S0, 4, 0, 2); SBAR(); \
    AT_VRD(13); SBAR(); AT_PVM(11); AT_A4C(S0, 8, 1, 0); SBAR(); \
    AT_VRD(14); SBAR(); AT_PVM(12); AT_A4C(S0, 12, 1, 2); SBAR(); \
    AT_VRD(15); SBAR(); AT_PVM(13); AT_A4C(S1, 0, 2, 0); SBAR(); \
    AT_KRD(0); AT_KRD(2); SBAR(); AT_PVM(14); AT_A2C(S1, 4, 2, 2); SBAR(); \
    AT_KRD(4); AT_KRD(6); SBAR(); AT_PVM(15); AT_A2C(S1, 6, 2, 3); SBAR(); \
    AT_KRD(1); SBAR(); S0 = MFMA32(kf[0], qf[0], zero16); AT_A4C(S1, 8, 3, 0); SBAR(); \
    AT_KRD(3); SBAR(); S0 = MFMA32(kf[2], qf[1], S0); AT_A2C(S1, 12, 3, 2); SBAR(); \
    AT_KRD(5); SBAR(); S0 = MFMA32(kf[4], qf[2], S0); AT_A2C(S1, 14, 3, 3); SBAR(); \
    AT_KRD(7); SBAR(); S0 = MFMA32(kf[6], qf[3], S0); lrun += sa_ + sb_; PINV(lrun); SBAR(); \
    S1 = MFMA32(kf[1], qf[0], zero16); SBAR(); D0; SBAR(); S1 = MFMA32(kf[3], qf[1], S1); SBAR(); D1; SBAR(); S1 = MFMA32(kf[5], qf[2], S1); SBAR(); D2; SBAR(); S1 = MFMA32(kf[7], qf[3], S1); SBAR(); D3; SBAR(); } while (0)
#define AT_FD0(i) const bf16_t* gk_ = uni_ptr(DKu + (size_t)((i) + 3) * 64 * 512); at_dma(gk_, kvo[0], lds0 + AT_K0 + k0 + w * 1024)
#define AT_FD1(i) at_dma(gk_, kvo[1], lds0 + AT_K0 + k0 + 8192 + w * 1024)
#define AT_FD2(i) const bf16_t* gv_ = uni_ptr(DVu + (size_t)((i) + 1) * 64 * 512); at_dma(gv_, vvo[0], lds0 + AT_V0 + vnext + w * 1024)
#define AT_FD3(i) at_dma(gv_, vvo[1], lds0 + AT_V0 + vnext + 8192 + w * 1024)
#define AT_VPRE() do { const LAS unsigned char* va0_ = L + AT_V0 + vprev + vb0; const LAS unsigned char* va1_ = L + AT_V0 + vprev + vb1; AT_VRD(0); AT_VRD(1); SBAR(); } while (0)
#define AT_PV_H() do { const LAS unsigned char* va0_ = L + AT_V0 + vprev + vb0; const LAS unsigned char* va1_ = L + AT_V0 + vprev + vb1; SBAR(); \
    AT_VRD(2); SBAR(); AT_PVM(0); SBAR(); AT_VRD(3); SBAR(); AT_PVM(1); SBAR(); AT_VRD(4); SBAR(); AT_PVM(2); SBAR(); AT_VRD(5); SBAR(); AT_PVM(3); SBAR(); AT_VRD(6); SBAR(); AT_PVM(4); SBAR(); AT_VRD(7); SBAR(); AT_PVM(5); SBAR(); \
    AT_VRD(8); SBAR(); AT_PVM(6); SBAR(); AT_VRD(9); SBAR(); AT_PVM(7); SBAR(); AT_VRD(10); SBAR(); AT_PVM(8); SBAR(); AT_VRD(11); SBAR(); AT_PVM(9); SBAR(); AT_VRD(12); SBAR(); AT_PVM(10); SBAR(); AT_VRD(13); SBAR(); AT_PVM(11); SBAR(); \
    AT_VRD(14); SBAR(); AT_PVM(12); SBAR(); AT_VRD(15); SBAR(); AT_PVM(13); SBAR(); AT_PVM(14); SBAR(); AT_PVM(15); SBAR(); } while (0)
#define AT_ROT() do { vprev = vcur; vcur = vnext; vnext = (vnext == 2 * AT_VB) ? 0 : vnext + AT_VB; { const int t_ = k0; k0 = k1; k1 = k2; k2 = t_; } } while (0)
#define AT_TAIL() do { AT_ROT(); AT_WAITBAR(); } while (0)
#define AT_TAIL4() do { AT_ROT(); AT_WAITBAR4(); } while (0)

template <bool SAFE>
__device__ __forceinline__ void attn_body(Frame& F) {
    LAS unsigned char* L = F.lds; const unsigned lds0 = (unsigned)(uintptr_t)F.lds;
    const bf16_t* DQ = (const bf16_t*)(F.ws + WS_DQ); const bf16_t* DK = (const bf16_t*)(F.ws + WS_DK); const bf16_t* DV = (const bf16_t*)(F.ws + WS_DV); bf16_t* Y = (bf16_t*)(F.ws + WS_XN);
    const int w = F.wave, c = w >> 2, jw = w & 3;
    const int cv_per = (CV_TOTAL + F.G * 8 - 1) / (F.G * 8); int cv_idx = (F.vcu * 8 + w) * cv_per, cv_cur = -1, cv_tick = 0; const int cv_end = min(CV_TOTAL, cv_idx + cv_per);
    LAS float* BT = (LAS float*)(L + AT_BIAS); LAS float* LAMP = (LAS float*)(L + AT_LAM);
    if (w == 0) { const int l0 = lane_id(); const float a = F.in[I_LQ1][l0] * F.in[I_LK1][l0], b = F.in[I_LQ2][l0] * F.in[I_LK2][l0];
        const float sa = wave_sum(a), sb = wave_sum(b); if (l0 == 0) LAMP[0] = __expf(sa) - __expf(sb) + 0.2f; }
    const float* relb = F.in[I_RELB]; LAS float* SUBG = (LAS float*)(L + AT_LAM + 64);
    { const int n = w * 64 + lane_id(); if (n < 128) SUBG[n] = F.in[I_SUBG][n]; }
#if defined(PROBE_AT)
    unsigned long long pa_far = 0, pa_nfar = 0, pa_seg[6] = {0, 0, 0, 0, 0, 0}, pa_min5 = ~0ull, pa_minb = ~0ull, pa_faru = 0; const unsigned long long pa_t0 = clock64();
#define PA_T(k) const unsigned long long pt##k = clock64()
#else
#define PA_T(k)
#endif
    for (int vv = F.vcu; vv < 256; vv += F.G) {
        const int bh = vv >> 3, sidx = vv & 7, h = bh & 3, b = bh >> 2; const size_t rowbase = (size_t)b * SEQ;
        __syncthreads();
        { const int n = w * 64 + lane_id(); if (n < 128) { int bucket = n;
            if (n >= 16) { bucket = 16 + (int)(__logf((float)n * (1.f / 16.f)) / __logf(8.f) * 16.f); if (bucket > 31) bucket = 31; }
            BT[n] = (relb[bucket * 4 + h] - relb[31 * 4 + h]) * LOG2E; } }
        bf16x8 qn[4];
#define AT_QLOAD(UI) do { const int pr_ = (UI) >> 1, qb_ = ((UI) & 1) ? (63 - 8 * pr_ - sidx) : (8 * pr_ + sidx); const int l_ = lane_id(); \
        const size_t qrow_ = rowbase + (size_t)(qb_ * 128 + 32 * (w & 3) + (l_ & 31)); \
        _Pragma("unroll") for (int ks = 0; ks < 4; ++ks) qn[ks] = *(const bf16x8*)(DQ + qrow_ * 512 + h * 128 + (w >> 2) * 64 + 16 * ks + 8 * (l_ >> 5)); } while (0)
        AT_QLOAD(0);
        for (int ui = 0; ui < 8; ++ui) {
            const int pr = ui >> 1, qb = (ui & 1) ? (63 - 8 * pr - sidx) : (8 * pr + sidx);
            PA_T(0);
            const int lane = lane_id(), hh = lane >> 5, ql = lane & 31, blk = (lane >> 4) & 1, q4 = (lane & 15) >> 2, p4 = lane & 3;
            const int vb0 = 64 * (4 * hh + q4) + 16 * ((2 * blk + (p4 >> 1)) ^ hh) + 8 * (p4 & 1), vb1 = 2048 + 64 * (4 * hh + q4) + 16 * ((2 * blk + (p4 >> 1)) ^ ((2 + hh) & 3)) + 8 * (p4 & 1);
            int kofs[4];
#pragma unroll
            for (int ks = 0; ks < 4; ++ks) kofs[ks] = c * 8192 + ql * 128 + 16 * ((2 * ks + hh) ^ ((ql >> 1) & 7));
            unsigned kvo[2], vvo[2];
#pragma unroll
            for (int p = 0; p < 2; ++p) { const int r = 8 * w + (lane >> 3), ch = (lane & 7) ^ ((r >> 1) & 7); kvo[p] = (unsigned)(r * 1024 + (h * 128 + p * 64 + 8 * ch) * 2);
                const int j = w + 8 * p, row = 8 * (j >> 1) + ((lane >> 2) & 7), chv = 4 * (2 * (j & 1) + (lane >> 5)) + ((lane & 3) ^ ((row >> 2) & 3)); vvo[p] = (unsigned)(row * 1024 + (h * 128 + 8 * chv) * 2); }
            const int q0 = qb * 128, NT = (q0 + 128) >> 6, qw0 = q0 + 32 * jw, qpos = qw0 + ql;
            const int NA = min(NT, ((qw0 + 31) >> 6) + 1);
            const bf16_t* DKu = DK + rowbase * 512; const bf16_t* DVu = DV + rowbase * 512;
            bf16x8 qf[4];
#pragma unroll
            for (int ks = 0; ks < 4; ++ks) qf[ks] = qn[ks];
#define AT_PROLOGUE_DMA() do { const bf16_t* g0 = uni_ptr(DKu); const bf16_t* g1 = uni_ptr(DKu + 64 * 512); const bf16_t* g2 = uni_ptr(DKu + 128 * 512); const bf16_t* gv = uni_ptr(DVu); \
                at_dma(g0, kvo[0], lds0 + AT_K0 + w * 1024); at_dma(g0, kvo[1], lds0 + AT_K0 + 8192 + w * 1024); \
                at_dma(g1, kvo[0], lds0 + AT_K0 + AT_KB + w * 1024); at_dma(g1, kvo[1], lds0 + AT_K0 + AT_KB + 8192 + w * 1024); \
                at_dma(g2, kvo[0], lds0 + AT_K0 + 2 * AT_KB + w * 1024); at_dma(g2, kvo[1], lds0 + AT_K0 + 2 * AT_KB + 8192 + w * 1024);          \
                at_dma(gv, vvo[0], lds0 + AT_V0 + w * 1024); at_dma(gv, vvo[1], lds0 + AT_V0 + 8192 + w * 1024); } while (0)
            if (ui == 0) { __syncthreads(); AT_PROLOGUE_DMA(); }
            f32x16 o[4];
#pragma unroll
            for (int eb = 0; eb < 4; ++eb) for (int i = 0; i < 16; ++i) o[eb][i] = 0.f;
            const f32x16 zero16 = {0.f, 0.f, 0.f, 0.f, 0.f, 0.f, 0.f, 0.f, 0.f, 0.f, 0.f, 0.f, 0.f, 0.f, 0.f, 0.f}; (void)zero16;
            float mref = 0.f, lrun = 0.f;
            f32x16 negm;
#pragma unroll
            for (int i = 0; i < 16; ++i) negm[i] = 0.f;
            bf16x8 pf[4];
#pragma unroll
            for (int k = 0; k < 4; ++k) pf[k] = (bf16x8){0, 0, 0, 0, 0, 0, 0, 0};
            int vprev = 0, vcur = 0, vnext = AT_VB, k0 = 0, k1 = AT_KB, k2 = 2 * AT_KB;
            AT_WAITBAR();
            PA_T(1);
            if (c == 1) __builtin_amdgcn_s_setprio(1);
            f32x16 s0, s1;
            { const LAS unsigned char* Kb = L + AT_K0; AT_QK(s0, s1, Kb); }
            u32x4 pw[4]; s16x4 vl[16], vh[16];
#pragma unroll
            for (int k = 0; k < 4; ++k) pw[k] = (u32x4){0u, 0u, 0u, 0u};
            asm volatile("s_waitcnt lgkmcnt(0)\n\ts_barrier" ::: "memory");
            PA_T(2);
            const int nfar = max(0, (qw0 - 112) >> 6);
            int i = 0;
            if constexpr (SAFE) {
#if defined(PROBE_AT)
                const unsigned long long pc0_ = clock64();
#endif
                for (; i < nfar; ++i) { AT_VPRE(); AT_CVSTEP(); AT_CORE_H(i, s0, s1, AT_FD0(i), AT_FD1(i), AT_FD2(i), AT_FD3(i)); AT_TAIL4(); }
#if defined(PROBE_AT)
                pa_faru = clock64() - pc0_; pa_far += pa_faru; pa_nfar += nfar;
#endif
                for (; i < NA; ++i) { AT_VPRE(); AT_HEAD(i); AT_BANDFIX(i, s0, s1); AT_CORE_H(i, s0, s1, , , , ); AT_TAIL(); }
                AT_VPRE(); AT_PV_H();
            } else {
                for (; i < nfar; ++i) { AT_HEAD_FAR(i); AT_CORE(i, s0, s1, pf); AT_TAIL4(); }
                for (; i < NA; ++i) { AT_HEAD(i); AT_BANDFIX(i, s0, s1); AT_CORE(i, s0, s1, pf); AT_TAIL(); }
                { const LAS unsigned char* Vp = L + AT_V0 + vprev; AT_PV(Vp, pf); }
            }
            PA_T(3);
            for (; i < NT; ++i) { AT_HEAD(i); AT_TAIL(); }
            PA_T(4);
            __builtin_amdgcn_s_setprio(0);
            if (cv_cur >= 0) { cv_convert(F, cv_cur, (const LAS float*)(L + AT_CV + w * 4096), lane); cv_cur = -1; }
            AT_WAITBAR();
            PA_T(5);
            if (ui < 7) { AT_PROLOGUE_DMA(); AT_QLOAD(ui + 1); }
            const float ltot = xsum32(lrun); const float inv = fast_rcp(ltot);
            const int lane2 = lane_id();
            const int ql2 = lane2 & 31, hh2 = lane2 >> 5;
            LAS float* X = (LAS float*)(L + AT_XCH) + jw * 4096;
            if (c == 1) { const float sc = inv * LAMP[0];
#pragma unroll
                for (int eb = 0; eb < 4; ++eb) for (int i = 0; i < 16; ++i) X[(eb * 16 + i) * 64 + lane2] = o[eb][i] * sc; }
            __syncthreads();
            if (c == 0) { float ss = 0.f;
#pragma unroll
                for (int eb = 0; eb < 4; ++eb) for (int i = 0; i < 16; ++i) { const float v = o[eb][i] * inv - X[(eb * 16 + i) * 64 + lane2]; o[eb][i] = v; ss += v * v; }
                ss = xsum32(ss);
                const float rs = __builtin_amdgcn_rsqf(ss * (1.f / 128.f) + EPS) * 0.8f;
                LDS_WAIT();
                LAS unsigned char* OS = (LAS unsigned char*)X;
#pragma unroll
                for (int eb = 0; eb < 4; ++eb)
#pragma unroll
                    for (int g4 = 0; g4 < 4; ++g4) { const int e = 32 * eb + 8 * g4 + 4 * hh2; const f32x4 gg = *(const LAS f32x4*)(SUBG + e);
                        u32x2 wv; wv.x = cvtpk(o[eb][4 * g4] * rs * gg[0], o[eb][4 * g4 + 1] * rs * gg[1]); wv.y = cvtpk(o[eb][4 * g4 + 2] * rs * gg[2], o[eb][4 * g4 + 3] * rs * gg[3]);
                        *(LAS u32x2*)(OS + ql2 * AT_OSTR + e * 2) = wv; }
                LDS_WAIT();
#pragma unroll
                for (int p = 0; p < 8; ++p) { const int idx = lane2 + 64 * p, r = idx >> 4, ch = idx & 15;
                    *(u32x4*)(Y + (rowbase + qw0 + r) * DM + 512 + h * 128 + 8 * ch) = *(const LAS u32x4*)(OS + r * AT_OSTR + 16 * ch); }
            }
#if defined(PROBE_AT)
            { const unsigned long long pt6 = clock64(); pa_seg[0] += pt1 - pt0; pa_seg[1] += pt2 - pt1; pa_seg[2] += pt3 - pt2; pa_seg[3] += pt4 - pt3; pa_seg[4] += pt5 - pt4; pa_seg[5] += pt6 - pt5; pa_min5 = min(pa_min5, pt6 - pt5); pa_minb = min(pa_minb, pt3 - pt2 - pa_faru); }
#endif
        }
    }
#if defined(PROBE_AT)
    if (F.vcu == 0 && w == 0 && lane_id() == 0) { const unsigned long long tot = clock64() - pa_t0; float v;
        if (PROBE_AT == 1) v = rintf((float)pa_far / (float)pa_nfar * 0.002f) * 500.f;
        else if (PROBE_AT == 2) v = rintf((float)pa_far / (float)tot * 50.f) * 20.f;
        else if (PROBE_AT == 3) v = rintf((float)tot * 1e-4f) * 10.f;
        else if (PROBE_AT == 16) v = rintf((float)(pa_seg[2] - pa_far) * (1.f / 8.f) * 0.002f) * 500.f;
        else if (PROBE_AT == 36) v = rintf((float)(pa_seg[2] - pa_far) * (1.f / 8.f) * 0.001f) * 1000.f;
        else if (PROBE_AT == 45) v = rintf((float)pa_seg[5] * (1.f / 8.f) * 0.001f) * 1000.f;
        else if (PROBE_AT == 46) v = rintf((float)pa_min5 * 0.002f) * 500.f;
        else if (PROBE_AT == 37) v = rintf((float)pa_minb * 0.002f) * 500.f;
        else if (PROBE_AT == 25) v = rintf((float)pa_seg[5] * (1.f / 8.f) * (1.f / 700.f)) * 700.f;
        else v = rintf((float)pa_seg[PROBE_AT - 10] * (1.f / 8.f) * 0.002f) * 500.f;
        ((float*)(F.ws + WS_WRF + 1048576))[0] = v; }
#endif
    __syncthreads();
    { const int lane = lane_id();
        for (;;) { if (cv_cur >= 0) { asm volatile("s_waitcnt vmcnt(0)" ::: "memory"); cv_convert(F, cv_cur, (const LAS float*)(L + AT_CV + w * 4096), lane); cv_cur = -1; }
            if (cv_idx >= cv_end) break;
            cv_issue(F, cv_idx, lds0 + AT_CV + w * 4096, lane); cv_cur = cv_idx; ++cv_idx; } }
}

__device__ __forceinline__ void attn_phase(Frame& F) {
    LAS float* FL = (LAS float*)(F.lds + AT_LAM);
    __syncthreads();
    if (F.wave == 0) { const int l0 = lane_id(); const float gq = fabsf(F.in[I_QG][l0]), gk = fabsf(F.in[I_KG][l0]);
        float mq = gq, mk = gk, bhi = 0.f, blo = 0.f;
#pragma unroll
        for (int o = 1; o < 64; o <<= 1) { mq = fmaxf(mq, __shfl_xor(mq, o)); mk = fmaxf(mk, __shfl_xor(mk, o)); }
        const float* relb = F.in[I_RELB];
        for (int i = 0; i < 128; ++i) { const float d = relb[i] - relb[124 + (i & 3)]; bhi = fmaxf(bhi, d); blo = fminf(blo, d); }
        const float qk = 8.f * mq * mk; const bool safe = (qk + bhi) * LOG2E < 60.f && (-qk + blo) * LOG2E > -60.f && qk == qk;
        if (l0 == 0) FL[1] = safe ? 1.f : 0.f; }
    __syncthreads();
    const bool safe = FL[1] != 0.f;
    if (safe) attn_body<true>(F); else attn_body<false>(F);
}
#undef AT_PV
#undef AT_VFR
#undef AT_QK
#undef AT_HEAD
#undef AT_HEAD_FAR
#undef AT_BANDFIX
#undef AT_CORE
#undef AT_TAIL
#undef AT_TAIL4
#undef AT_E3
#undef AT_A4C
#undef AT_A2C
#undef AT_QLOAD
#undef AT_PROLOGUE_DMA
#undef AT_ROT
#undef AT_VPRE
#undef AT_WAITBAR4
#undef AT_CORE_H
#undef AT_PV_H
#undef AT_GX
#undef AT_GS
#undef AT_GA
#undef AT_KRD
#undef AT_PVM
#undef AT_VF
#undef AT_VRD
#undef AT_CVSTEP
#undef AT_WAITBAR
constexpr int RT_TSTR = 272;
constexpr int RT_TILE = 0, RT_LOG = 8 * 32 * RT_TSTR, RT_RS = RT_LOG + 8 * 32 * 33 * 4, RT_CNT = RT_RS + 8 * 32 * 4, RT_BASE = RT_CNT + 128;
template <bool REAL>
__device__ __forceinline__ void route_phase(Frame& F) {
    LAS unsigned char* L = F.lds;
    const float* H = F.in[I_X]; const bf16_t* Y1 = (const bf16_t*)(F.ws + WS_Y1); unsigned char* M2 = F.ws + WS_XN; const float* gn = F.in[I_N2G]; const float* br = F.in[I_BR];
    const bf16_t* wrf = (const bf16_t*)(F.ws + WS_WRF); int* ldst = (int*)(F.ws + WS_LDST); float* lgate = (float*)(F.ws + WS_LGATE); float* lrs = (float*)(F.ws + WS_LRS);
    const int tid = (F.wave * 64 + lane_id()), lane = lane_id(), w = F.wave, hh = lane >> 5, l31 = lane & 31;
    LAS unsigned char* TL = L + RT_TILE + w * 32 * RT_TSTR; LAS float* LG = (LAS float*)(L + RT_LOG) + w * 32 * 33; LAS float* RS = (LAS float*)(L + RT_RS) + w * 32;
    LAS int* CNT = (LAS int*)(L + RT_CNT); LAS int* BASE = (LAS int*)(L + RT_BASE);
    for (int bt = F.vcu; bt < T / 256; bt += F.G) {
        const size_t row0 = (size_t)bt * 256 + 32 * w;
        if (tid < 32) CNT[tid] = 0;
        f32x16 acc; for (int i = 0; i < 16; ++i) acc[i] = 0.f;
        float ss[16];
#pragma unroll
        for (int i = 0; i < 16; ++i) ss[i] = 0.f;
        for (int ch = 0; ch < 8; ++ch) { const int col = 128 * ch + 4 * l31; const f32x4 g = *(const f32x4*)(gn + col);
            f32x4 hv[16];
#pragma unroll
            for (int i = 0; i < 16; ++i) hv[i] = *(const f32x4*)(H + (row0 + 2 * i + hh) * DM + col);
            u32x2 yv[16];
#pragma unroll
            for (int i = 0; i < 16; ++i) yv[i] = *(const u32x2*)(Y1 + (row0 + 2 * i + hh) * DM + col);
#pragma unroll
            for (int i = 0; i < 16; ++i) { hv[i].x += bflo(yv[i].x); hv[i].y += bfhi(yv[i].x); hv[i].z += bflo(yv[i].y); hv[i].w += bfhi(yv[i].y); }
#pragma unroll
            for (int i = 0; i < 16; ++i) { const int r = 2 * i + hh; ss[i] += (hv[i].x * hv[i].x + hv[i].y * hv[i].y) + (hv[i].z * hv[i].z + hv[i].w * hv[i].w); const f32x4 v = hv[i] * g;
                u32x2 wv; wv.x = cvtpk(v.x, v.y); wv.y = cvtpk(v.z, v.w);
                *(unsigned*)(M2 + (row0 + r) * DM + col) = pk4_fp8(v.x, v.y, v.z, v.w); *(LAS u32x2*)(TL + r * RT_TSTR + 8 * l31) = wv; }
            LDS_WAIT();
#pragma unroll
            for (int ks = 0; ks < 8; ++ks) { const bf16x8 a = *(const LAS bf16x8*)(TL + l31 * RT_TSTR + (16 * ks + 8 * hh) * 2); const bf16x8 bfr = *(const bf16x8*)(wrf + ((size_t)(8 * ch + ks) * 64 + lane) * 8);
                acc = MFMA32(a, bfr, acc); }
            LDS_WAIT();
        }
#pragma unroll
        for (int i = 0; i < 16; ++i) { float s = ss[i];
#pragma unroll
            for (int o = 1; o < 32; o <<= 1) s += __shfl_xor(s, o);
            if (l31 == 0) RS[2 * i + hh] = __builtin_amdgcn_rsqf(s * (1.f / DM) + EPS); }
#pragma unroll
        for (int i = 0; i < 16; ++i) LG[crow(i, hh) * 33 + l31] = acc[i];
        LDS_WAIT();
        __syncthreads();
        int ek[4] = {0, 0, 0, 0}; float gk[4] = {0.f, 0.f, 0.f, 0.f}; int pk[4] = {0, 0, 0, 0};
        if (lane < 32) { float v[32];
            const float rsl = RS[lane];
#pragma unroll
            for (int e = 0; e < 32; ++e) v[e] = LG[lane * 33 + e] * rsl + br[e];
            unsigned taken = 0u; float tv[4];
#pragma unroll
            for (int k = 0; k < 4; ++k) { float best = -3.0e38f; int bi = 0;
#pragma unroll
                for (int e = 0; e < 32; ++e) { const bool ok = !((taken >> e) & 1u) && v[e] > best; best = ok ? v[e] : best; bi = ok ? e : bi; }
                taken |= 1u << bi; ek[k] = bi; tv[k] = best; }
            const float e1 = __expf(tv[1] - tv[0]), e2 = __expf(tv[2] - tv[0]), e3 = __expf(tv[3] - tv[0]); const float inv = 1.f / (1.f + e1 + e2 + e3);
            gk[0] = inv; gk[1] = e1 * inv; gk[2] = e2 * inv; gk[3] = e3 * inv;
#pragma unroll
            for (int k = 0; k < 4; ++k) pk[k] = __hip_atomic_fetch_add(CNT + ek[k], 1, __ATOMIC_RELAXED, __HIP_MEMORY_SCOPE_WORKGROUP); }
        __syncthreads();
        if (tid < 32) BASE[tid] = REAL ? (int)__hip_atomic_fetch_add(F.ctl + CW_CNT + 64 * tid, (unsigned)CNT[tid], RLX_AGENT) : 0;
        __syncthreads();
        if (lane < 32 && REAL) { const int tok = (int)row0 + lane;
#pragma unroll
            for (int k = 0; k < 4; ++k) { const int p = BASE[ek[k]] + pk[k]; ldst[ek[k] * 65536 + p] = tok * 4 + k; lgate[ek[k] * 65536 + p] = gk[k]; lrs[ek[k] * 65536 + p] = RS[lane]; } }
        __syncthreads();
    }
}

template <bool REAL>
__device__ __forceinline__ void combine_phase(Frame& F) {
    const int gw = F.vcu * 8 + F.wave, NGW = F.G * 8;
    const unsigned char* Y0 = F.ws + WS_YS0; const unsigned char* Y1 = F.ws + WS_YS1; const unsigned char* Y2 = F.ws + WS_YS2; const unsigned char* Y3 = F.ws + WS_YS3;
    for (int m0 = gw; m0 < T; m0 += 2 * NGW) {
        f32x4 o[2][4]; u32x2 yy[2][4]; unsigned x[2][4], y[2][4], z[2][4], q[2][4];
#pragma unroll
        for (int r = 0; r < 2; ++r) { const int m = m0 + r * NGW; if (m < T) { const f32x4* op = (const f32x4*)(F.in[I_X] + (size_t)m * DM) + lane_id(); const u32x2* yp = (const u32x2*)((const bf16_t*)(F.ws + WS_Y1) + (size_t)m * DM) + lane_id();
            const unsigned* a = (const unsigned*)(Y0 + (size_t)m * DM) + lane_id(); const unsigned* b = (const unsigned*)(Y1 + (size_t)m * DM) + lane_id(); const unsigned* c = (const unsigned*)(Y2 + (size_t)m * DM) + lane_id(); const unsigned* d = (const unsigned*)(Y3 + (size_t)m * DM) + lane_id();
#pragma unroll
            for (int j = 0; j < 4; ++j) { o[r][j] = op[64 * j]; yy[r][j] = yp[64 * j]; x[r][j] = a[64 * j]; y[r][j] = b[64 * j]; z[r][j] = c[64 * j]; q[r][j] = d[64 * j]; } } }
#pragma unroll
        for (int r = 0; r < 2; ++r) { const int m = m0 + r * NGW; if (m < T) { f32x4* op = (f32x4*)(F.out + (size_t)m * DM) + lane_id();
#pragma unroll
            for (int j = 0; j < 4; ++j) { f32x4 v = o[r][j]; v.x += bflo(yy[r][j].x); v.y += bfhi(yy[r][j].x); v.z += bflo(yy[r][j].y); v.w += bfhi(yy[r][j].y);
                const f32x2 xl = __builtin_amdgcn_cvt_pk_f32_fp8(x[r][j], false), xh = __builtin_amdgcn_cvt_pk_f32_fp8(x[r][j], true), yl = __builtin_amdgcn_cvt_pk_f32_fp8(y[r][j], false), yh = __builtin_amdgcn_cvt_pk_f32_fp8(y[r][j], true);
                const f32x2 zl = __builtin_amdgcn_cvt_pk_f32_fp8(z[r][j], false), zh = __builtin_amdgcn_cvt_pk_f32_fp8(z[r][j], true), ql = __builtin_amdgcn_cvt_pk_f32_fp8(q[r][j], false), qh = __builtin_amdgcn_cvt_pk_f32_fp8(q[r][j], true);
                const f32x2 sl = (xl + yl) + (zl + ql), sh = (xh + yh) + (zh + qh);
                v.x += sl.x * YSCALE_INV; v.y += sl.y * YSCALE_INV; v.z += sh.x * YSCALE_INV; v.w += sh.y * YSCALE_INV;
                if (REAL) op[64 * j] = v; else ((f32x4*)(F.ws + WS_HID + (size_t)m * DM * 4) + lane_id())[64 * j] = v; } } }
    }
}

#ifndef PROBE_DUP
#define PROBE_DUP -1
#endif
#ifndef P5_STAGGER_TICKS
#define P5_STAGGER_TICKS 0
#endif
struct Args { const float* in[22]; float* out; unsigned char* ws; int ph_lo, ph_hi; };
constexpr int NPHASE = 10;
__global__ void __launch_bounds__(512, 2) hymba_fwd(Args args) {
    extern __shared__ __attribute__((aligned(16))) unsigned char lds[];
    Frame F;
    F.lds = (LAS unsigned char*)lds;
    F.wave = __builtin_amdgcn_readfirstlane((int)threadIdx.x >> 6);
    F.G = gridDim.x; { const int bx = blockIdx.x; F.vcu = (F.G % 8 == 0) ? (bx % 8) * (F.G / 8) + bx / 8 : bx; }
    F.ws = args.ws; F.out = args.out; F.ctl = (gu32*)(args.ws + WS_CTL);
#pragma unroll
    for (int i = 0; i < 22; ++i) F.in[i] = args.in[i];
    if ((F.wave * 64 + lane_id()) < 64) ((LAS unsigned*)(F.lds + LDS_CTL_OFF))[(F.wave * 64 + lane_id())] = 0u;
    __syncthreads();
    const int lo = args.ph_lo, hi = args.ph_hi;
    const bool multi = (hi - lo) > 1;
    XcdBarrier bar; bar.bar = (unsigned*)(F.ctl + CW_BAR); bar.x = 0; bar.st = nullptr; bar.wave = F.wave;
    if (multi) bar = xcd_barrier_post((unsigned*)(F.ctl + CW_BAR), (volatile LAS unsigned*)(F.lds + LDS_CTL_OFF), F.wave);
#define IN(k) (lo <= (k) && (k) < hi)
#if defined(PROBE_PH)
#define PH_STAMP(k) do { if (blockIdx.x == 0 && F.wave == 0 && lane_id() == 0) ((LAS unsigned long long*)(F.lds + LDS_CTL_OFF + 512))[k] = __builtin_amdgcn_s_memrealtime(); } while (0)
#else
#define PH_STAMP(k)
#endif
#define SEAM(k) do { if (IN(k) && IN((k) + 1)) xcd_barrier(bar); PH_STAMP((k) + 1); } while (0)
    PH_STAMP(0);
    if (IN(0)) { p0_prologue(F); if (PROBE_DUP == 0) { __syncthreads(); p0_prologue(F); } } SEAM(0);
    if (IN(1)) { pg8::DenseOrder S; S.init(F.ws + WS_XN, F.ws + WS_WIN, T, NIN, DM, F.G, (int)blockIdx.x);
        { LAS float* tb = (LAS float*)(F.lds + LDS_TAB_OFF); const int tid = F.wave * 64 + lane_id();
            if (tid < 256) tb[tid] = F.in[I_BG2][tid]; else if (tid < 320) tb[tid] = F.in[I_QG][tid - 256]; else if (tid < 384) tb[tid] = F.in[I_KG][tid - 320];
            __syncthreads(); }
        EpiInProj E{F.ws, (const LAS float*)(F.lds + LDS_TAB_OFF), (const LAS float*)(F.lds + LDS_TAB_OFF) + 256, (const LAS float*)(F.lds + LDS_TAB_OFF) + 320};
        pg8::gemm_phase<EpiInProj, pg8::DenseOrder>(F.lds, DM * 2, F.wave, S, E); if (PROBE_DUP == 1) { __syncthreads(); pg8::gemm_phase<EpiInProj, pg8::DenseOrder>(F.lds, DM * 2, F.wave, S, E); } } SEAM(1);
    if (IN(2)) { if (PROBE_DUP == 2) { gla_g01<false>(F); __syncthreads(); } gla_g01<true>(F); } SEAM(2);
    if (IN(3)) { if (PROBE_DUP == 3) { gla_scan<false>(F); __syncthreads(); } gla_scan<true>(F); } SEAM(3);
#if defined(PROBE_CLK)
    unsigned long long pc0 = 0, pt0 = 0;
    if (IN(4)) { pc0 = clock64(); pt0 = __builtin_amdgcn_s_memrealtime(); }
#endif
    if (IN(4)) { attn_phase(F); __syncthreads();
#if defined(PROBE_CLK)
        { const unsigned long long pc1 = clock64(), pt1 = __builtin_amdgcn_s_memrealtime();
          if (blockIdx.x == 0 && F.wave == 0 && lane_id() == 0) { float v;
              if (PROBE_CLK == 0) v = (float)(pc1 - pc0) / (float)(pt1 - pt0) * 10.f;
              else v = (float)(pt1 - pt0) * 0.001f;
              ((float*)(F.ws + WS_WRF + 1048576))[0] = rintf(v * 0.5f) * 2.f; } }
#endif
 if (PROBE_DUP == 4) { attn_phase(F); __syncthreads(); } gla_g3(F); if (PROBE_DUP == 41) { __syncthreads(); gla_g3(F); } } SEAM(4);
    if (IN(5)) { pg8::DenseOrder S; S.init(F.ws + WS_XN, F.ws + WS_WOUT, T, DM, DM, F.G, (int)blockIdx.x);
        if (P5_STAGGER_TICKS > 0 && (F.vcu & 1)) { const unsigned long long t0 = __builtin_amdgcn_s_memrealtime(); while (__builtin_amdgcn_s_memrealtime() - t0 < (unsigned long long)P5_STAGGER_TICKS) __builtin_amdgcn_s_sleep(16); }
        EpiResid E{(bf16_t*)(F.ws + WS_Y1)};
        pg8::gemm_phase<EpiResid, pg8::DenseOrder>(F.lds, DM * 2, F.wave, S, E); if (PROBE_DUP == 5) { __syncthreads(); pg8::gemm_phase<EpiResid, pg8::DenseOrder>(F.lds, DM * 2, F.wave, S, E); } } SEAM(5);
    if (IN(6)) { if (PROBE_DUP == 6) { route_phase<false>(F); __syncthreads(); } route_phase<true>(F); } SEAM(6);
    if (IN(7) || IN(8)) {
        LAS int* tab = (LAS int*)(F.lds + LDS_TAB_OFF);
        __syncthreads();
        if ((F.wave * 64 + lane_id()) == 0) { int ts = 0, rp = 0;
            for (int e = 0; e < 32; ++e) { const int c = (int)__hip_atomic_load(F.ctl + CW_CNT + 64 * e, RLX_AGENT); tab[e] = ts; tab[40 + e] = rp; tab[80 + e] = c; ts += (c + 255) >> 8; rp += c; }
            tab[32] = ts; tab[72] = rp; }
        __syncthreads();
        { const int MT = tab[32];
            for (int m = F.wave * 64 + lane_id(); m < MT; m += 512) { int e = 0;
#pragma unroll 1
                for (int s2 = 16; s2 >= 1; s2 >>= 1) if (tab[e + s2] <= m) e += s2;
                const int mt = m - tab[e], rows = min(256, tab[80 + e] - mt * 256);
                tab[128 + 2 * m] = e | (mt << 5) | (rows << 14); tab[129 + 2 * m] = tab[40 + e] + mt * 256; } }
        __syncthreads();
    }
    if (IN(7)) { MoeOrder S{(const LAS int*)(F.lds + LDS_TAB_OFF), F.G, F.vcu, 3, 1, (const char*)(F.ws + WS_XN), (const char*)(F.ws + WS_WGU), (const int*)(F.ws + WS_LDST), (const float*)(F.ws + WS_LRS), nullptr, F.in[I_BGU]};
        EpiGateUp E{F.ws + WS_HID, (const LAS float*)(F.lds + LDS_TAB_OFF) + 2816, (const LAS float*)(F.lds + LDS_TAB_OFF) + 2304};
        pg8::gemm_phase<EpiGateUp, MoeOrder, true>(F.lds, DM, F.wave, S, E); if (PROBE_DUP == 7) { __syncthreads(); pg8::gemm_phase<EpiGateUp, MoeOrder, true>(F.lds, DM, F.wave, S, E); } } SEAM(7);
    if (IN(8)) { MoeOrder S{(const LAS int*)(F.lds + LDS_TAB_OFF), F.G, F.vcu, 2, 0, (const char*)(F.ws + WS_HID), (const char*)(F.ws + WS_WD), (const int*)(F.ws + WS_LDST), nullptr, (const float*)(F.ws + WS_LGATE), F.in[I_BD]};
        EpiDown E{F.ws, (const LAS float*)(F.lds + LDS_TAB_OFF) + 2816, (const LAS int*)(F.lds + LDS_TAB_OFF) + 2304, (const LAS float*)(F.lds + LDS_TAB_OFF) + 3072};
        if (PROBE_DUP == 8) { pg8::gemm_phase<EpiDown, MoeOrder, true>(F.lds, DM, F.wave, S, E); __syncthreads(); }
        pg8::gemm_phase<EpiDown, MoeOrder, true>(F.lds, DM, F.wave, S, E); } SEAM(8);
    if (IN(9)) { if (PROBE_DUP == 9) { combine_phase<false>(F); __syncthreads(); } combine_phase<true>(F);
#if defined(PROBE_PH)
        __syncthreads(); PH_STAMP(10);
        if (blockIdx.x == 0 && F.wave == 0 && lane_id() == 0) { const LAS unsigned long long* ts = (const LAS unsigned long long*)(F.lds + LDS_CTL_OFF + 512);
            const float us = (float)(ts[PROBE_PE] - ts[PROBE_PH]) * 0.01f;
#if defined(PROBE_THR)
            F.out[0] = us > PROBE_THR ? 1000.f : 500.f; }
#else
            F.out[0] = rintf(us * (1.f / PROBE_Q)) * PROBE_Q; }
#endif
#endif
#if defined(PROBE_CLK) || defined(PROBE_AT)
        if (F.vcu == 0 && F.wave == 0 && lane_id() == 0) { asm volatile("s_waitcnt vmcnt(0)" ::: "memory"); F.out[0] = ((volatile float*)(F.ws + WS_WRF + 1048576))[0]; }
#endif
    }
#undef IN
#undef SEAM
}

#ifndef MK_N_LAUNCHES
#define MK_N_LAUNCHES 1
#endif
extern "C" void kernel_launch(void* const* d_in, const int* in_sizes, int n_in, void* d_out, int out_size, void* d_ws, size_t ws_size, hipStream_t stream) {
    static int grid = 0;
    if (grid == 0) {
        if (n_in != 22 || in_sizes[0] != T * DM || out_size != T * DM || ws_size < WS_END) { fprintf(stderr, "kernel_launch: unexpected shapes / workspace (n_in %d, ws %zu)\n", n_in, ws_size); grid = -1; return; }
        int dev = 0, cus = 0, per_cu = 0;
        if (hipGetDevice(&dev) != hipSuccess || hipDeviceGetAttribute(&cus, hipDeviceAttributeMultiprocessorCount, dev) != hipSuccess) { grid = -1; return; }
        if (hipFuncSetAttribute((const void*)hymba_fwd, hipFuncAttributeMaxDynamicSharedMemorySize, LDS_BYTES) != hipSuccess) { fprintf(stderr, "kernel_launch: hipFuncSetAttribute failed\n"); grid = -1; return; }
        if (hipOccupancyMaxActiveBlocksPerMultiprocessor(&per_cu, (const void*)hymba_fwd, 512, LDS_BYTES) != hipSuccess || per_cu < 1) fprintf(stderr, "kernel_launch: occupancy query says %d\n", per_cu);
        (void)hipGetLastError();
        grid = cus;
    }
    if (grid < 0) return;
    if (hipMemsetAsync((char*)d_ws + WS_CTL, 0, CTL_ZERO_BYTES, stream) != hipSuccess) return;
    Args a{};
    for (int i = 0; i < 22; ++i) a.in[i] = (const float*)d_in[i];
    a.out = (float*)d_out; a.ws = (unsigned char*)d_ws;
    if (MK_N_LAUNCHES == 1) { a.ph_lo = 0; a.ph_hi = NPHASE; hipLaunchKernelGGL(hymba_fwd, dim3(grid), dim3(512), LDS_BYTES, stream, a); }
    else for (int p = 0; p < NPHASE; ++p) { a.ph_lo = p; a.ph_hi = p + 1; hipLaunchKernelGGL(hymba_fwd, dim3(grid), dim3(512), LDS_BYTES, stream, a); }
}
```
